# Optimizing an MI355X kernel written in HIP

```python
import jax, jax.numpy as jnp
from jax import lax
import numpy as np

D_MODEL = 1024
BATCH = 4
SEQ = 4096
DEPTH = 4

CHUNK = 64
Q_BLOCK = 128
MIX_WIDTH = D_MODEL

RW_HEADS = 8
RW_HEAD_DIM = 64
RW_WIDTH = RW_HEADS * RW_HEAD_DIM
RW_DECAY_LORA = 64
RW_AAA_LORA = 64
RW_GATE_LORA = 128
RW_GN_EPS = 64e-5

MLA_HEADS = 4
MLA_NOPE_DIM = 64
MLA_ROPE_DIM = 32
MLA_V_DIM = 64
MLA_QK_DIM = MLA_NOPE_DIM + MLA_ROPE_DIM
MLA_Q_RANK = 256
MLA_KV_RANK = 128
MLA_WIDTH = MLA_HEADS * MLA_V_DIM
ROPE_THETA = 10000.0

SB_HEADS = 4
SB_HEAD_DIM = 64
SB_WIDTH = SB_HEADS * SB_HEAD_DIM

FFN_HIDDEN = -(-8 * D_MODEL // (3 * 256)) * 256

NORM_EPS = 1e-6
NEG_INF = -1e30

RW_SPLITS = (RW_WIDTH, RW_WIDTH, RW_WIDTH, RW_DECAY_LORA, RW_AAA_LORA, RW_GATE_LORA)
RW_COLS = sum(RW_SPLITS)
REST_SPLITS = (MLA_Q_RANK, MLA_KV_RANK, MLA_ROPE_DIM, SB_WIDTH, SB_WIDTH, SB_WIDTH)
IN_COLS = RW_COLS + sum(REST_SPLITS)

kernel_name = "hybrid_rwkv7_mla_stickbreak_trunk"


def _split_points(sizes):
    return [int(v) for v in np.cumsum(sizes)[:-1]]


def rms_norm(x, g):
    xf = x.astype(jnp.float32)
    y = xf * lax.rsqrt(jnp.mean(xf * xf, axis=-1, keepdims=True) + NORM_EPS)
    return (y * g.astype(jnp.float32)).astype(x.dtype)


def token_shift(p, mu):
    prev = jnp.pad(p, ((0, 0), (1, 0), (0, 0)))[:, :-1]
    return p + mu * (prev - p)


def to_heads(t, n_heads):
    B, T, C = t.shape
    return t.reshape(B, T, n_heads, C // n_heads).transpose(0, 2, 1, 3)


def from_heads(t):
    B, H, T, d = t.shape
    return t.transpose(0, 2, 1, 3).reshape(B, T, H * d)


def rotary_tables(positions):
    inv_freq = ROPE_THETA ** (-jnp.arange(0, MLA_ROPE_DIM, 2, dtype=jnp.float32) / MLA_ROPE_DIM)
    ang = positions.astype(jnp.float32)[..., None] * inv_freq
    return jnp.cos(ang)[:, :, None, :], jnp.sin(ang)[:, :, None, :]


def apply_rotary(x, cos, sin):
    xf = x.astype(jnp.float32)
    x1, x2 = jnp.split(xf, 2, axis=-1)
    return jnp.concatenate([x1 * cos - x2 * sin, x1 * sin + x2 * cos], axis=-1).astype(x.dtype)


def rwkv7_time_mix(r, k, v, wd, ad, gd, w_up, w0, a_up, a0, g_up, k_k, k_a, r_k, ln_g, ln_b):
    B, T, _ = r.shape
    f32 = jnp.float32
    w = -jax.nn.softplus(-(w0 + jnp.tanh(wd) @ w_up)) - 0.5
    decay = jnp.exp(-jnp.exp(w.astype(f32)))
    a = jax.nn.sigmoid(a0 + ad @ a_up)
    g = jax.nn.sigmoid(gd) @ g_up
    heads = lambda t: t.reshape(B, T, RW_HEADS, RW_HEAD_DIM).astype(f32)
    kk = heads(k * k_k)
    kk = kk * lax.rsqrt(jnp.sum(kk * kk, axis=-1, keepdims=True) + 1e-12)
    k = k * (1 + (a - 1) * k_a)
    rh, kh, vh, wh, ah = heads(r), heads(k), heads(v), heads(decay), heads(a)
    a_vec = -kk
    b_vec = kk * ah

    def step(S, inp):
        r_t, w_t, k_t, v_t, a_t, b_t = inp
        sa = jnp.einsum('bhij,bhj->bhi', S, a_t)
        S = S * w_t[:, :, None, :] + sa[..., None] * b_t[:, :, None, :] + v_t[..., None] * k_t[:, :, None, :]
        return S, jnp.einsum('bhij,bhj->bhi', S, r_t)

    seq = tuple(jnp.swapaxes(t, 0, 1) for t in (rh, wh, kh, vh, a_vec, b_vec))
    S0 = jnp.zeros((B, RW_HEADS, RW_HEAD_DIM, RW_HEAD_DIM), f32)
    _, y = lax.scan(step, S0, seq)
    y = jnp.swapaxes(y, 0, 1)
    mu = jnp.mean(y, axis=-1, keepdims=True)
    var = jnp.mean(jnp.square(y - mu), axis=-1, keepdims=True)
    y = ((y - mu) * lax.rsqrt(var + RW_GN_EPS)).reshape(B, T, RW_WIDTH) * ln_g.astype(f32) + ln_b.astype(f32)
    bonus = jnp.sum(rh * kh * r_k.astype(f32), axis=-1, keepdims=True) * vh
    y = y + bonus.reshape(B, T, RW_WIDTH)
    return (y * g.astype(f32)).astype(r.dtype)


def chunk_causal_softmax_attention(q, k, v, scale):
    B, H, T, dk = q.shape
    nb = T // Q_BLOCK
    qb = jnp.moveaxis(q.reshape(B, H, nb, Q_BLOCK, dk), 2, 0)
    k_chunk = jnp.arange(T) // CHUNK

    def one_block(args):
        q_blk, i = args
        q_chunk = (i * Q_BLOCK + jnp.arange(Q_BLOCK)) // CHUNK
        s = jnp.einsum('bhqd,bhkd->bhqk', q_blk, k).astype(jnp.float32) * scale
        s = jnp.where(k_chunk[None, :] <= q_chunk[:, None], s, NEG_INF)
        p = jax.nn.softmax(s, axis=-1).astype(v.dtype)
        return jnp.einsum('bhqk,bhkd->bhqd', p, v)

    out = lax.map(one_block, (qb, jnp.arange(nb)))
    return jnp.moveaxis(out, 0, 2).reshape(B, H, T, v.shape[-1])


def stick_breaking_attention(q, k, v):
    B, H, T, d = q.shape
    nb = T // Q_BLOCK
    qb = jnp.moveaxis(q.reshape(B, H, nb, Q_BLOCK, d), 2, 0)
    k_pos = jnp.arange(T)
    scale = d ** -0.5

    def one_block(args):
        q_blk, i = args
        q_pos = i * Q_BLOCK + jnp.arange(Q_BLOCK)
        strict = k_pos[None, :] < q_pos[:, None]
        z = jnp.einsum('bhqd,bhkd->bhqk', q_blk, k).astype(jnp.float32) * scale
        log_stay = jnp.where(strict, jax.nn.log_sigmoid(-z), 0.0)
        shifted = jnp.pad(log_stay[..., 1:], ((0, 0), (0, 0), (0, 0), (0, 1)))
        log_after = lax.cumsum(shifted, axis=3, reverse=True)
        w = jnp.where(strict, jnp.exp(jax.nn.log_sigmoid(z) + log_after), 0.0)
        return jnp.einsum('bhqk,bhkd->bhqd', w.astype(v.dtype), v)

    out = lax.map(one_block, (qb, jnp.arange(nb)))
    return jnp.moveaxis(out, 0, 2).reshape(B, H, T, d)


def setup_inputs(seed: int = 0) -> dict:
    key = jax.random.key(seed)
    ks = iter(jax.random.split(key, 32))
    f32 = jnp.float32
    L = DEPTH

    def nrm(shape, scale):
        return jax.random.normal(next(ks), shape, f32) * scale

    def gain(shape):
        return 1.0 + nrm(shape, 0.02)

    x = jax.random.normal(next(ks), (BATCH, SEQ, D_MODEL), f32)
    offsets = jax.random.randint(next(ks), (BATCH, 1), 0, 8192, dtype=jnp.int32)
    positions = offsets + jnp.arange(SEQ, dtype=jnp.int32)[None, :]
    return {
        "x": x,
        "positions": positions,
        "attn_norm_g": gain((L, D_MODEL)),
        "w_in": nrm((L, D_MODEL, IN_COLS), D_MODEL ** -0.5),
        "rw_shift_mu": jax.random.uniform(next(ks), (L, RW_COLS), f32),
        "rw_w_up": nrm((L, RW_DECAY_LORA, RW_WIDTH), 0.5 * RW_DECAY_LORA ** -0.5),
        "rw_w0": jax.random.uniform(next(ks), (L, RW_WIDTH), f32, -6.0, 0.0),
        "rw_a_up": nrm((L, RW_AAA_LORA, RW_WIDTH), RW_AAA_LORA ** -0.5),
        "rw_a0": nrm((L, RW_WIDTH), 0.1),
        "rw_g_up": nrm((L, RW_GATE_LORA, RW_WIDTH), RW_GATE_LORA ** -0.5),
        "rw_k_k": 0.85 + nrm((L, RW_WIDTH), 0.02),
        "rw_k_a": gain((L, RW_WIDTH)),
        "rw_r_k": nrm((L, RW_HEADS, RW_HEAD_DIM), 0.1),
        "rw_ln_g": gain((L, RW_WIDTH)),
        "rw_ln_b": nrm((L, RW_WIDTH), 0.02),
        "mla_cq_norm_g": gain((L, MLA_Q_RANK)),
        "mla_ckv_norm_g": gain((L, MLA_KV_RANK)),
        "mla_w_uq": nrm((L, MLA_Q_RANK, MLA_HEADS * MLA_QK_DIM), MLA_Q_RANK ** -0.5),
        "mla_w_ukv": nrm((L, MLA_KV_RANK, MLA_HEADS * (MLA_NOPE_DIM + MLA_V_DIM)), MLA_KV_RANK ** -0.5),
        "mla_q_norm_g": gain((L, MLA_QK_DIM)),
        "mla_k_norm_g": gain((L, MLA_QK_DIM)),
        "w_o": nrm((L, MIX_WIDTH, D_MODEL), MIX_WIDTH ** -0.5),
        "ffn_norm_g": gain((L, D_MODEL)),
        "ffn_w_gate": nrm((L, D_MODEL, FFN_HIDDEN), D_MODEL ** -0.5),
        "ffn_w_up": nrm((L, D_MODEL, FFN_HIDDEN), D_MODEL ** -0.5),
        "ffn_w_down": nrm((L, FFN_HIDDEN, D_MODEL), FFN_HIDDEN ** -0.5),
    }


def reference(x, positions, attn_norm_g, w_in, rw_shift_mu, rw_w_up, rw_w0, rw_a_up, rw_a0, rw_g_up,
              rw_k_k, rw_k_a, rw_r_k, rw_ln_g, rw_ln_b, mla_cq_norm_g, mla_ckv_norm_g, mla_w_uq, mla_w_ukv,
              mla_q_norm_g, mla_k_norm_g, w_o, ffn_norm_g, ffn_w_gate, ffn_w_up, ffn_w_down):
    B, T, _ = x.shape
    cos, sin = rotary_tables(positions)
    rw_pts = _split_points(RW_SPLITS)
    rest_pts = _split_points(REST_SPLITS)
    for l in range(DEPTH):
        h = rms_norm(x, attn_norm_g[l]) @ w_in[l]
        rw_cols = token_shift(h[..., :RW_COLS], rw_shift_mu[l])
        r, k, v, wd, ad, gd = jnp.split(rw_cols, rw_pts, axis=-1)
        c_q, c_kv, k_rope, sb_q, sb_k, sb_v = jnp.split(h[..., RW_COLS:], rest_pts, axis=-1)

        y_rw = rwkv7_time_mix(r, k, v, wd, ad, gd, rw_w_up[l], rw_w0[l], rw_a_up[l], rw_a0[l], rw_g_up[l],
                              rw_k_k[l], rw_k_a[l], rw_r_k[l], rw_ln_g[l], rw_ln_b[l])

        q = (rms_norm(c_q, mla_cq_norm_g[l]) @ mla_w_uq[l]).reshape(B, T, MLA_HEADS, MLA_QK_DIM)
        kv = (rms_norm(c_kv, mla_ckv_norm_g[l]) @ mla_w_ukv[l]).reshape(B, T, MLA_HEADS, MLA_NOPE_DIM + MLA_V_DIM)
        k_nope, v_mla = jnp.split(kv, [MLA_NOPE_DIM], axis=-1)
        k_full = jnp.concatenate(
            [k_nope, jnp.broadcast_to(k_rope[:, :, None, :], (B, T, MLA_HEADS, MLA_ROPE_DIM))], axis=-1)
        q = rms_norm(q, mla_q_norm_g[l])
        k_full = rms_norm(k_full, mla_k_norm_g[l])
        q = jnp.concatenate([q[..., :MLA_NOPE_DIM], apply_rotary(q[..., MLA_NOPE_DIM:], cos, sin)], axis=-1)
        k_full = jnp.concatenate(
            [k_full[..., :MLA_NOPE_DIM], apply_rotary(k_full[..., MLA_NOPE_DIM:], cos, sin)], axis=-1)
        o_mla = chunk_causal_softmax_attention(
            q.transpose(0, 2, 1, 3), k_full.transpose(0, 2, 1, 3), v_mla.transpose(0, 2, 1, 3),
            MLA_QK_DIM ** -0.5)
        y_mla = from_heads(o_mla)

        o_sb = stick_breaking_attention(to_heads(sb_q, SB_HEADS), to_heads(sb_k, SB_HEADS), to_heads(sb_v, SB_HEADS))
        y_sb = from_heads(o_sb)

        mixed = jnp.concatenate([y_rw, y_mla.astype(y_rw.dtype), y_sb.astype(y_rw.dtype)], axis=-1)
        x = x + (mixed @ w_o[l]).astype(x.dtype)

        hn = rms_norm(x, ffn_norm_g[l])
        x = x + ((jax.nn.silu(hn @ ffn_w_gate[l]) * (hn @ ffn_w_up[l])) @ ffn_w_down[l]).astype(x.dtype)
    return x
```

```cpp
#include <hip/hip_runtime.h>
#include <hip/hip_cooperative_groups.h>
#include <cstdio>
#include <cstdint>
namespace cg = cooperative_groups;

#define LAS __attribute__((address_space(3)))
typedef float f32x16 __attribute__((ext_vector_type(16)));
typedef float f32x2 __attribute__((ext_vector_type(2)));
typedef unsigned u32x2 __attribute__((ext_vector_type(2)));
typedef short s16x4 __attribute__((ext_vector_type(4)));
namespace pg8 {
#define PG8_LAS __attribute__((address_space(3)))
typedef unsigned short bf16_t;
typedef short bf16x8 __attribute__((ext_vector_type(8)));
typedef float f32x4 __attribute__((ext_vector_type(4)));
typedef unsigned u32x4 __attribute__((ext_vector_type(4)));
constexpr int BM = 256, BK = 64, HALF = 128, HTB = HALF * BK * 2  , STAGE_BYTES = 8 * HTB, NXCD = 8, WGM = 8;

__host__ __device__ __forceinline__ int lds_byte(int r, int c) { const int st = (r >> 4) * 2 + (c >> 5), rr = r & 15, cc = c & 31, ob = rr * 64 + cc * 2; return st * 1024 + (ob ^ (((ob >> 9) & 1) << 5)); }
__host__ __device__ __forceinline__ void stage_rc(int b, int& R, int& C) { const int st = b / 1024, sb = b % 1024, swz = sb ^ (((sb >> 9) & 1) << 5); R = (st >> 1) * 16 + swz / 64; C = (st & 1) * 32 + (swz % 64) / 2; }
__host__ __device__ __forceinline__ int perm32(int rho) { const int n = rho >> 4, i = rho & 15; return 8 * (i >> 2) + 4 * n + (i & 3); }

struct Unit { int pm, pn; };
struct Gemm { const bf16_t* A; const bf16_t* Bt; int M, N, K; };

struct StaticOrder {
    int nM, nN, nwg, G, c;
    __host__ __device__ void init(int M, int N, int G_, int c_) { nM = M / BM; nN = N / BM; nwg = nM * nN; G = G_; c = c_; }
    __host__ __device__ bool next(int i, Unit& u) const {
        const long L = (long)i * G + c; if (L >= nwg) return false;
        int wgid = (int)L; { const int q = nwg / NXCD, r = nwg % NXCD, xcd = wgid % NXCD, off = wgid / NXCD; wgid = (xcd < r ? xcd * (q + 1) : r * (q + 1) + (xcd - r) * q) + off; }
        const int nig = WGM * nN, gid = wgid / nig, fm = gid * WGM, gsz = (nM - fm) < WGM ? (nM - fm) : WGM;
        u.pm = fm + ((wgid % nig) % gsz); u.pn = (wgid % nig) / gsz; return true;
    }
    __device__ __forceinline__ void a_ready(const Unit&) const {}
    __device__ __forceinline__ void done(const Unit&) const {}
};
typedef float f32x2_t_ __attribute__((ext_vector_type(2))); typedef __bf16 bf16x2_t_ __attribute__((ext_vector_type(2)));
__device__ __forceinline__ unsigned cvt_pk_bf16(float lo, float hi) { f32x2_t_ v = {lo, hi}; bf16x2_t_ b = __builtin_convertvector(v, bf16x2_t_); return __builtin_bit_cast(unsigned, b); }


template <class Epi, class Sched, bool ALIGN_EPI = false, bool SP2 = false>
__device__ __forceinline__ void gemm_phase(PG8_LAS unsigned char* lds, const Gemm g, const Sched& S, const Epi& E) {
    int tid_ = threadIdx.x; asm volatile("" : "+v"(tid_)); const int tid = tid_, wid = __builtin_amdgcn_readfirstlane(tid >> 6), lane = tid & 63, wr = wid >> 2, wc = wid & 3, fr = lane & 15, fq = lane >> 4;
    const int K = g.K, nt = K / BK;
    unsigned voffA[2], voffB[2];
#pragma unroll
    for (int i = 0; i < 2; ++i) { int R, C; stage_rc(tid * 16 + i * 8192, R, C); const int Rb = Epi::PERM ? ((R & ~31) + perm32(R & 31)) : R;
        voffA[i] = (unsigned)(R * K + C) * 2u; voffB[i] = (unsigned)(Rb * K + C) * 2u; }
    const size_t kstep = (size_t)(BK * 2);
    const size_t hstep = (size_t)HALF * K * 2;
    const size_t tstep = 2 * hstep;
    const unsigned ldsw = (unsigned)wid * 1024u;
    const int aoff = lds_byte(wr * 64 + fr, fq * 8), boff = lds_byte(wc * 32 + fr, fq * 8);
#define PG8_SA(b, h) (((b) * 2 + (h)) * HTB)
#define PG8_SB(b, h) ((4 + (b) * 2 + (h)) * HTB)
#define PG8_STAGE(bufoff, gbase, voff) do { _Pragma("unroll") for (int _i = 0; _i < 2; ++_i) { unsigned _vo = (voff)[_i]; asm volatile("" : "+v"(_vo)); \
        __builtin_amdgcn_global_load_lds((const unsigned*)((const char*)(gbase) + _vo), (PG8_LAS unsigned*)(lds + (bufoff) + ldsw + _i * 8192), 16, 0, 0); } } while (0)
#define PG8_LDA(dst, b, h) do { _Pragma("unroll") for (int m = 0; m < 4; ++m) _Pragma("unroll") for (int k = 0; k < 2; ++k) dst[m][k] = *(const PG8_LAS bf16x8*)(lds + PG8_SA(b, h) + aoff + m * 2048 + k * 1024); } while (0)
#define PG8_LDB(dst, b, h) do { _Pragma("unroll") for (int n = 0; n < 2; ++n) _Pragma("unroll") for (int k = 0; k < 2; ++k) dst[n][k] = *(const PG8_LAS bf16x8*)(lds + PG8_SB(b, h) + boff + n * 2048 + k * 1024); } while (0)
#define PG8_MMA(ai, bj, At, Bt) do { __builtin_amdgcn_s_setprio(1); _Pragma("unroll") for (int m = 0; m < 4; ++m) _Pragma("unroll") for (int n = 0; n < 2; ++n) _Pragma("unroll") for (int k = 0; k < 2; ++k) \
        acc[ai][bj][m][n] = __builtin_amdgcn_mfma_f32_16x16x32_bf16(Bt[n][k], At[m][k], acc[ai][bj][m][n], 0, 0, 0); __builtin_amdgcn_s_setprio(0); } while (0)
#define PG8_WAIT_V(n) asm volatile("s_waitcnt vmcnt(" #n ")" ::: "memory")
#define PG8_WAIT_L(n) asm volatile("s_waitcnt lgkmcnt(" #n ")" ::: "memory")
#define PG8_BAR __builtin_amdgcn_s_barrier()
#define PG8_SCHED __builtin_amdgcn_sched_barrier(0)
    Unit cur, nxt; int ui = 0;
    if (!S.next(0, cur)) return;
    f32x4 acc[2][2][4][2];
#pragma unroll
    for (int a = 0; a < 2; ++a)
#pragma unroll
        for (int b = 0; b < 2; ++b)
#pragma unroll
            for (int m = 0; m < 4; ++m)
#pragma unroll
                for (int n = 0; n < 2; ++n) acc[a][b][m][n] = (f32x4){0.f, 0.f, 0.f, 0.f};
    bf16x8 At[4][2], B0[2][2], B1[2][2];
    const char* cA = (const char*)g.A + (size_t)cur.pm * tstep; const char* cB = (const char*)g.Bt + (size_t)cur.pn * tstep;
    S.a_ready(cur);
    if constexpr (SP2) {
        PG8_STAGE(PG8_SB(0, 0), cB, voffB); PG8_STAGE(PG8_SB(0, 1), cB + hstep, voffB); PG8_STAGE(PG8_SA(0, 0), cA, voffA); PG8_STAGE(PG8_SA(0, 1), cA + hstep, voffA);
        if (wr == 1) PG8_BAR;
        PG8_WAIT_V(2); PG8_BAR;
        PG8_STAGE(PG8_SB(1, 0), cB + kstep, voffB); PG8_STAGE(PG8_SA(1, 0), cA + kstep, voffA); PG8_STAGE(PG8_SB(1, 1), cB + hstep + kstep, voffB);
        PG8_WAIT_V(6); PG8_BAR;
    } else {
        PG8_STAGE(PG8_SB(0, 0), cB, voffB); PG8_STAGE(PG8_SA(0, 0), cA, voffA); PG8_STAGE(PG8_SB(0, 1), cB + hstep, voffB); PG8_STAGE(PG8_SA(0, 1), cA + hstep, voffA);
        if (wr == 1) PG8_BAR;
        PG8_WAIT_V(4); PG8_BAR;
        PG8_STAGE(PG8_SB(1, 0), cB + kstep, voffB); PG8_STAGE(PG8_SA(1, 0), cA + kstep, voffA); PG8_STAGE(PG8_SB(1, 1), cB + hstep + kstep, voffB);
        PG8_WAIT_V(6); PG8_BAR;
    }
    for (;;) {
        const bool has_next = S.next(ui + 1, nxt);
        const char* nA = has_next ? (const char*)g.A + (size_t)nxt.pm * tstep : cA; const char* nB = has_next ? (const char*)g.Bt + (size_t)nxt.pn * tstep : cB;
        for (int t = 0; t < nt; t += 2) {
            const bool last = (t == nt - 2);
            const char* a1 = cA + (size_t)(t + 1) * kstep;
            const char* a2 = last ? nA : cA + (size_t)(t + 2) * kstep; const char* b2 = last ? nB : cB + (size_t)(t + 2) * kstep;
            const char* a3 = a2 + kstep; const char* b3 = b2 + kstep;
            if (last && has_next) S.a_ready(nxt);
            if constexpr (SP2) {
            PG8_LDB(B0, 0, 0); PG8_LDB(B1, 0, 1); PG8_SCHED; PG8_LDA(At, 0, 0); PG8_STAGE(PG8_SA(1, 1), a1 + hstep, voffA);
            PG8_WAIT_V(8); PG8_WAIT_L(0); PG8_BAR; PG8_MMA(0, 0, At, B0); PG8_MMA(0, 1, At, B1); PG8_BAR; PG8_SCHED;
            PG8_LDA(At, 0, 1); PG8_STAGE(PG8_SB(0, 0), b2, voffB); PG8_STAGE(PG8_SB(0, 1), b2 + hstep, voffB); PG8_STAGE(PG8_SA(0, 0), a2, voffA);
            PG8_WAIT_V(8); PG8_WAIT_L(0); PG8_BAR; PG8_MMA(1, 0, At, B0); PG8_MMA(1, 1, At, B1); PG8_BAR; PG8_SCHED;
            PG8_LDB(B0, 1, 0); PG8_LDB(B1, 1, 1); PG8_SCHED; PG8_LDA(At, 1, 0); PG8_STAGE(PG8_SA(0, 1), a2 + hstep, voffA);
            PG8_WAIT_V(8); PG8_WAIT_L(0); PG8_BAR; PG8_MMA(0, 0, At, B0); PG8_MMA(0, 1, At, B1); PG8_BAR; PG8_SCHED;
            PG8_LDA(At, 1, 1); PG8_STAGE(PG8_SB(1, 0), b3, voffB); PG8_STAGE(PG8_SB(1, 1), b3 + hstep, voffB); PG8_STAGE(PG8_SA(1, 0), a3, voffA);
            PG8_WAIT_V(8); PG8_WAIT_L(0); PG8_BAR; PG8_MMA(1, 0, At, B0); PG8_MMA(1, 1, At, B1); PG8_BAR; PG8_SCHED;
            } else {
            PG8_LDB(B0, 0, 0); PG8_SCHED; PG8_LDA(At, 0, 0); PG8_STAGE(PG8_SA(1, 1), a1 + hstep, voffA);
            PG8_WAIT_L(8); PG8_BAR; PG8_WAIT_L(0); PG8_MMA(0, 0, At, B0); PG8_BAR; PG8_SCHED;
            PG8_LDB(B1, 0, 1); PG8_STAGE(PG8_SB(0, 0), b2, voffB);
            PG8_BAR; PG8_WAIT_L(0); PG8_MMA(0, 1, At, B1); PG8_BAR;
            PG8_LDA(At, 0, 1); PG8_STAGE(PG8_SA(0, 0), a2, voffA);
            PG8_BAR; PG8_WAIT_L(0); PG8_MMA(1, 0, At, B0); PG8_BAR; PG8_SCHED;
            PG8_STAGE(PG8_SB(0, 1), b2 + hstep, voffB);
            PG8_WAIT_V(6); PG8_BAR; PG8_MMA(1, 1, At, B1); PG8_BAR;
            PG8_LDB(B0, 1, 0); PG8_SCHED; PG8_LDA(At, 1, 0); PG8_STAGE(PG8_SA(0, 1), a2 + hstep, voffA);
            PG8_WAIT_L(8); PG8_BAR; PG8_WAIT_L(0); PG8_MMA(0, 0, At, B0); PG8_BAR; PG8_SCHED;
            PG8_LDB(B1, 1, 1); PG8_STAGE(PG8_SB(1, 0), b3, voffB);
            PG8_BAR; PG8_WAIT_L(0); PG8_MMA(0, 1, At, B1); PG8_BAR;
            PG8_LDA(At, 1, 1); PG8_STAGE(PG8_SA(1, 0), a3, voffA);
            PG8_BAR; PG8_WAIT_L(0); PG8_MMA(1, 0, At, B0); PG8_BAR; PG8_SCHED;
            PG8_STAGE(PG8_SB(1, 1), b3 + hstep, voffB);
            PG8_WAIT_V(6); PG8_BAR; PG8_MMA(1, 1, At, B1); PG8_BAR;
            }
        }
        if constexpr (ALIGN_EPI) { if (wr == 0) PG8_BAR; }
        if constexpr (!Epi::AFTER_DRAIN) { E(acc, cur, wr, wc, fr, fq); S.done(cur); }
        if (!has_next) break;
#pragma unroll
        for (int a = 0; a < 2; ++a)
#pragma unroll
            for (int b = 0; b < 2; ++b)
#pragma unroll
                for (int m = 0; m < 4; ++m)
#pragma unroll
                    for (int n = 0; n < 2; ++n) acc[a][b][m][n] = (f32x4){0.f, 0.f, 0.f, 0.f};
        cur = nxt; cA = nA; cB = nB; ++ui;
        if constexpr (ALIGN_EPI) { if (wr == 1) PG8_BAR; }
    }
    PG8_WAIT_V(0);
    if constexpr (!ALIGN_EPI) { if (wr == 0) PG8_BAR; }
    PG8_BAR;
    if constexpr (Epi::AFTER_DRAIN) { E.fused(acc, cur, wr, wc, fr, fq, lds, wid, lane); S.done(cur); }
#undef PG8_SA
#undef PG8_SB
#undef PG8_STAGE
#undef PG8_LDA
#undef PG8_LDB
#undef PG8_MMA
#undef PG8_WAIT_V
#undef PG8_WAIT_L
#undef PG8_BAR
#undef PG8_SCHED
}
}

using pg8::bf16_t; using pg8::bf16x8; using pg8::f32x4; using pg8::u32x4; using pg8::cvt_pk_bf16;

constexpr int NTOK = 16384, SEQ = 4096, DM = 1024, DEPTH = 4;
constexpr int HB = 2304, HS = 768, FF = 2816, INC = 2976;
constexpr int NTHR = 512;
constexpr int LDS_BYTES = 147456;
constexpr int LDS_ITEM_OFF = LDS_BYTES - 64;
constexpr int P2_CONV = 128;
constexpr int P2_ITEMS = 128 + 512 + P2_CONV;

constexpr size_t MiB = 1u << 20;
constexpr size_t WS_CTR = 0, WS_SSQ = 4096, WS_SMALLW = 1 * MiB, WS_WIN = 4 * MiB, WS_WO = 10 * MiB, WS_WGU = 12 * MiB, WS_WDN = 23 * MiB,
                 WS_HBIG = 29 * MiB, WS_ACT = 29 * MiB, WS_MLA = 101 * MiB, WS_MIXED = 133 * MiB, WS_HSMALL = 165 * MiB, WS_STREAMS = 189 * MiB,
                 WS_XB = 189 * MiB, WS_SSQ64 = 253 * MiB, WS_BAR = 254 * MiB + 512 * 1024, WS_END = 255 * MiB;
constexpr size_t SMALLW_LAYER = 589824;
constexpr size_t SW_WUP = 0, SW_AUP = 65536, SW_GUP = 131072, SW_UQ = 262144, SW_UKV = 458752;
constexpr size_t STREAM_BYTES = (size_t)NTOK * 512 * 2;
constexpr size_t MLA_Q = 0, MLA_K = 12 * MiB, MLA_V = 24 * MiB;

struct Params {
    const float* x; const int* pos; const float* attn_norm_g; const float* w_in; const float* mu; const float* w_up; const float* w0;
    const float* a_up; const float* a0; const float* g_up; const float* k_k; const float* k_a; const float* r_k; const float* ln_g;
    const float* ln_b; const float* cq_g; const float* ckv_g; const float* w_uq; const float* w_ukv; const float* qn_g; const float* kn_g;
    const float* w_o; const float* ffn_g; const float* w_gate; const float* w_upf; const float* w_down;
    float* out; unsigned char* ws;
    int ph_lo, ph_hi;
};

__device__ __forceinline__ float bflo(unsigned u) { return __uint_as_float(u << 16); }
__device__ __forceinline__ float bfhi(unsigned u) { return __uint_as_float(u & 0xffff0000u); }
__device__ __forceinline__ float bf1(bf16_t b) { return __uint_as_float((unsigned)b << 16); }
__device__ __forceinline__ bf16_t f2bf(float f) { return (bf16_t)(cvt_pk_bf16(f, 0.f) & 0xffffu); }
__device__ __forceinline__ float wave_sum(float v) {
#pragma unroll
    for (int o = 1; o < 64; o <<= 1) v += __shfl_xor(v, o);
    return v;
}
#define LDS_WAIT() asm volatile("s_waitcnt lgkmcnt(0)" ::: "memory")
#define LDS_BARRIER() asm volatile("s_waitcnt lgkmcnt(0)\n\ts_barrier" ::: "memory")
__device__ __forceinline__ float sigmoidf_(float x) { return __builtin_amdgcn_rcpf(1.f + __expf(-x)); }
__device__ __forceinline__ float softplusf_(float x) { return fmaxf(x, 0.f) + __logf(1.f + __expf(-fabsf(x))); }
__device__ __forceinline__ float shiftf(float cur, float prev, float mu) { return cur + mu * (prev - cur); }
#define DPP_ROR_ADD(x, n) ((x) + __builtin_bit_cast(float, __builtin_amdgcn_update_dpp(0, __builtin_bit_cast(int, (x)), 0x120 + (n), 0xf, 0xf, false)))
__device__ __forceinline__ float row16_sum(float x) {
    x = DPP_ROR_ADD(x, 8); x = DPP_ROR_ADD(x, 4); x = DPP_ROR_ADD(x, 2); x = DPP_ROR_ADD(x, 1); return x;
}

__device__ __forceinline__ void tr_item(const float* W, int K, int N, int sc, const float* g, bf16_t* WT, int drow0, LAS float* scr, int k0, int lane) {
#pragma unroll
    for (int i = 0; i < 32; ++i) {
        const int kk = 2 * i + (lane >> 5); float v = 0.f;
        if (sc >= 0) { v = W[(size_t)(k0 + kk) * N + sc]; if (g) v *= g[k0 + kk]; }
        scr[kk * 33 + (lane & 31)] = v;
    }
    LDS_WAIT();
    const int c = lane & 7;
#pragma unroll
    for (int j = 0; j < 4; ++j) {
        const int n = (lane >> 3) + 8 * j; const LAS float* s = scr + (8 * c) * 33 + n;
        u32x4 o; o.x = cvt_pk_bf16(s[0 * 33], s[1 * 33]); o.y = cvt_pk_bf16(s[2 * 33], s[3 * 33]); o.z = cvt_pk_bf16(s[4 * 33], s[5 * 33]); o.w = cvt_pk_bf16(s[6 * 33], s[7 * 33]);
        *(u32x4*)(WT + (size_t)(drow0 + n) * K + k0 + 8 * c) = o;
    }
    LDS_WAIT();
}
__device__ __forceinline__ void conv_run(const float* src0, const float* src1, const float* g, bf16_t* dst, int K, int Ns, int Nd, int mode,
                                         LAS float* scr, int gw, int ngw, int lane) {
    asm volatile("" : "+v"(lane));
    const int nnb = Nd / 32, nitems = (K / 64) * nnb;
    for (int it = gw; it < nitems; it += ngw) {
        const int kb = it / nnb, nb = it - kb * nnb, n = nb * 32 + (lane & 31);
        const float* src = src0; int sc;
        if (mode == 0) sc = n;
        else if (mode == 1) sc = n < 1536 ? n : (n < 2304 ? n + 672 : (n < 2976 ? n - 768 : -1));
        else { const int blk = n >> 8, jj = n & 255; if (jj < 128) sc = blk * 128 + jj; else { src = src1; sc = blk * 128 + jj - 128; } }
        tr_item(src, K, Ns, sc, g, dst, nb * 32, scr, kb * 64, lane);
    }
}

struct EpiH {
    static constexpr bool PERM = true, AFTER_DRAIN = false;
    bf16_t* hbig; bf16_t* hsmall; const unsigned long long* ssq;
    __device__ __forceinline__ void operator()(const f32x4 (&acc)[2][2][4][2], const pg8::Unit& u, int wr, int wc, int fr, int fq) const {
        int row0 = u.pm * 256 + wr * 64 + fr; asm volatile("" : "+v"(row0));
        bf16_t* dst; int ld, c0;
        if (u.pn < 9) { dst = hbig; ld = HB; c0 = u.pn * 256; } else { dst = hsmall; ld = HS; c0 = u.pn * 256 - HB; }
        const int col0 = c0 + wc * 32 + 8 * fq;
#pragma unroll
        for (int ai = 0; ai < 2; ++ai)
#pragma unroll
            for (int m = 0; m < 4; ++m) {
                const int row = row0 + ai * 128 + m * 16;
                const float rinv = rsqrtf((float)ssq[row] * (1.f / (1024.f * 16777216.f)) + 1e-6f);
#pragma unroll
                for (int bj = 0; bj < 2; ++bj) {
                    const f32x4 v0 = acc[ai][bj][m][0] * rinv, v1 = acc[ai][bj][m][1] * rinv;
                    u32x4 w; w.x = cvt_pk_bf16(v0[0], v0[1]); w.y = cvt_pk_bf16(v0[2], v0[3]); w.z = cvt_pk_bf16(v1[0], v1[1]); w.w = cvt_pk_bf16(v1[2], v1[3]);
                    *(u32x4*)(dst + (size_t)row * ld + col0 + bj * 128) = w;
                }
            }
    }
};
struct EpiRes {
    static constexpr bool PERM = true, AFTER_DRAIN = false;
    const float* xin; float* xout; bf16_t* xb; unsigned long long* ssq_out;
    __device__ __forceinline__ void operator()(const f32x4 (&acc)[2][2][4][2], const pg8::Unit& u, int wr, int wc, int fr, int fq) const {
        int row0 = u.pm * 256 + wr * 64 + fr, col0 = u.pn * 256 + wc * 32 + 8 * fq; asm volatile("" : "+v"(row0), "+v"(col0));
#pragma unroll
        for (int ai = 0; ai < 2; ++ai)
#pragma unroll
            for (int m = 0; m < 4; ++m) {
                const int row = row0 + ai * 128 + m * 16; float s = 0.f;
#pragma unroll
                for (int bj = 0; bj < 2; ++bj) {
                    const size_t off = (size_t)row * DM + col0 + bj * 128;
                    const f32x4 x0 = *(const f32x4*)(xin + off), x1 = *(const f32x4*)(xin + off + 4);
                    const f32x4 v0 = x0 + acc[ai][bj][m][0], v1 = x1 + acc[ai][bj][m][1];
                    *(f32x4*)(xout + off) = v0; *(f32x4*)(xout + off + 4) = v1;
                    u32x4 w; w.x = cvt_pk_bf16(v0[0], v0[1]); w.y = cvt_pk_bf16(v0[2], v0[3]); w.z = cvt_pk_bf16(v1[0], v1[1]); w.w = cvt_pk_bf16(v1[2], v1[3]);
                    *(u32x4*)(xb + off) = w;
                    s += v0[0] * v0[0] + v0[1] * v0[1] + v0[2] * v0[2] + v0[3] * v0[3] + v1[0] * v1[0] + v1[1] * v1[1] + v1[2] * v1[2] + v1[3] * v1[3];
                }
                s += __shfl_xor(s, 16); s += __shfl_xor(s, 32);
                if (fq == 0) atomicAdd(ssq_out + row, (unsigned long long)(s * 16777216.f));
            }
    }
};
struct EpiGLU {
    static constexpr bool PERM = true, AFTER_DRAIN = false;
    bf16_t* act; const unsigned long long* ssq;
    __device__ __forceinline__ void operator()(const f32x4 (&acc)[2][2][4][2], const pg8::Unit& u, int wr, int wc, int fr, int fq) const {
        int row0 = u.pm * 256 + wr * 64 + fr, col0 = u.pn * 128 + wc * 32 + 8 * fq; asm volatile("" : "+v"(row0), "+v"(col0));
#pragma unroll
        for (int ai = 0; ai < 2; ++ai)
#pragma unroll
            for (int m = 0; m < 4; ++m) {
                const int row = row0 + ai * 128 + m * 16;
                const float rinv = rsqrtf((float)ssq[row] * (1.f / (1024.f * 16777216.f)) + 1e-6f);
                float o[8];
#pragma unroll
                for (int n = 0; n < 2; ++n)
#pragma unroll
                    for (int j = 0; j < 4; ++j) { const float g = acc[ai][0][m][n][j] * rinv, up = acc[ai][1][m][n][j] * rinv; o[n * 4 + j] = g * __builtin_amdgcn_rcpf(1.f + __expf(-g)) * up; }
                u32x4 w; w.x = cvt_pk_bf16(o[0], o[1]); w.y = cvt_pk_bf16(o[2], o[3]); w.z = cvt_pk_bf16(o[4], o[5]); w.w = cvt_pk_bf16(o[6], o[7]);
                *(u32x4*)(act + (size_t)row * FF + col0) = w;
            }
    }
};

__device__ __forceinline__ void phase_prologue(const Params& p, LAS unsigned char* lds) {
    int tid_ = threadIdx.x; asm volatile("" : "+v"(tid_)); const int tid = tid_, lane = tid & 63, wave = tid >> 6;
    const int gw = blockIdx.x * 8 + wave, ngw = gridDim.x * 8;
    LAS float* scr = (LAS float*)(lds + wave * 8448);
    unsigned char* ws = p.ws;
    conv_run(p.w_in, nullptr, p.attn_norm_g, (bf16_t*)(ws + WS_WIN), 1024, INC, 3072, 1, scr, gw, ngw, lane);
    for (int l = 0; l < DEPTH; ++l) {
        unsigned char* sw = ws + WS_SMALLW + l * SMALLW_LAYER;
        const int g0 = (gw + ngw - (l * 5 + 0) * 96) % ngw, g1 = (gw + ngw - (l * 5 + 1) * 96) % ngw, g2 = (gw + ngw - (l * 5 + 2) * 96) % ngw,
                  g3 = (gw + ngw - (l * 5 + 3) * 96) % ngw, g4 = (gw + ngw - (l * 5 + 4) * 96) % ngw;
        conv_run(p.w_up + (size_t)l * 64 * 512, nullptr, nullptr, (bf16_t*)(sw + SW_WUP), 64, 512, 512, 0, scr, g0, ngw, lane);
        conv_run(p.a_up + (size_t)l * 64 * 512, nullptr, nullptr, (bf16_t*)(sw + SW_AUP), 64, 512, 512, 0, scr, g1, ngw, lane);
        conv_run(p.g_up + (size_t)l * 128 * 512, nullptr, nullptr, (bf16_t*)(sw + SW_GUP), 128, 512, 512, 0, scr, g2, ngw, lane);
        conv_run(p.w_uq + (size_t)l * 256 * 384, nullptr, p.cq_g + l * 256, (bf16_t*)(sw + SW_UQ), 256, 384, 384, 0, scr, g3, ngw, lane);
        conv_run(p.w_ukv + (size_t)l * 128 * 512, nullptr, p.ckv_g + l * 128, (bf16_t*)(sw + SW_UKV), 128, 512, 512, 0, scr, g4, ngw, lane);
    }
    unsigned long long* ssq = (unsigned long long*)(ws + WS_SSQ64);
    bf16_t* xb = (bf16_t*)(ws + WS_XB);
#pragma unroll 2
    for (int m = gw; m < NTOK; m += ngw) {
        const f32x4* xr = (const f32x4*)(p.x + (size_t)m * DM) + lane;
        f32x4 v[4]; float s = 0.f;
#pragma unroll
        for (int j = 0; j < 4; ++j) { v[j] = xr[64 * j]; s += v[j][0] * v[j][0] + v[j][1] * v[j][1] + v[j][2] * v[j][2] + v[j][3] * v[j][3]; }
        s = wave_sum(s);
        if (lane == 0) ssq[m] = (unsigned long long)(s * 16777216.f);
#pragma unroll
        for (int j = 0; j < 4; ++j) { u32x2 w; w.x = cvt_pk_bf16(v[j][0], v[j][1]); w.y = cvt_pk_bf16(v[j][2], v[j][3]); *(u32x2*)(xb + (size_t)m * DM + 256 * j + 4 * lane) = w; }
    }
    for (int i = blockIdx.x * NTHR + tid; i < 8 * NTOK; i += gridDim.x * NTHR) ssq[NTOK + i] = 0ull;
    if (blockIdx.x == 0 && tid < 16) ((unsigned*)(ws + WS_CTR))[tid] = 0u;
}

constexpr int PA_W = 0, PA_A = 9216, PA_G = 18432, PA_Q = 35840, PA_KV = 69632, PA_RQ = 87040, PA_RKV = 87296, PA_COS = 87552, PA_SIN = 91648, PA_QG = 95744, PA_KG = 96128;

template <int K, int JOB>
__device__ __forceinline__ void lora_job(const LAS bf16_t* A, const bf16_t* Bt, bf16_t* dst, const float* biasp, int tok0, int wave, int fr, int fq) {
    constexpr int NKS = K / 32, lda = K + 8;
    asm volatile("" : "+v"(fr), "+v"(fq));
#pragma unroll 1
    for (int q = 0; q < 4; ++q) {
        const int col = (wave * 4 + q) * 16 + fr;
        bf16x8 bfrq[NKS];
#pragma unroll
        for (int ks = 0; ks < NKS; ++ks) bfrq[ks] = *(const bf16x8*)(Bt + (size_t)col * K + ks * 32 + fq * 8);
        __builtin_amdgcn_sched_barrier(0);
        f32x4 acc[4];
#pragma unroll
        for (int m = 0; m < 4; ++m) acc[m] = (f32x4){0.f, 0.f, 0.f, 0.f};
#pragma unroll
        for (int ks = 0; ks < NKS; ++ks)
#pragma unroll
            for (int m = 0; m < 4; ++m) {
                const bf16x8 afr = *(const LAS bf16x8*)(A + (m * 16 + fr) * lda + ks * 32 + fq * 8);
                acc[m] = __builtin_amdgcn_mfma_f32_16x16x32_bf16(afr, bfrq[ks], acc[m], 0, 0, 0);
            }
        const float bias = (JOB == 2) ? 0.f : biasp[col];
#pragma unroll
        for (int m = 0; m < 4; ++m)
#pragma unroll
            for (int r = 0; r < 4; ++r) {
                float v = acc[m][r] + bias;
                if (JOB == 0) { const float wr_ = -softplusf_(-v) - 0.5f; v = -__expf(wr_); }
                else if (JOB == 1) v = sigmoidf_(v);
                dst[(size_t)(tok0 + m * 16 + fq * 4 + r) * 512 + col] = f2bf(v);
            }
    }
}
__device__ __forceinline__ void phase_prep(const Params& p, int l, LAS unsigned char* lds) {
    int tid_ = threadIdx.x; asm volatile("" : "+v"(tid_)); const int tid = tid_, lane = tid & 63, wave = tid >> 6;
    const int gw = blockIdx.x * 8 + wave, ngw = gridDim.x * 8;
    unsigned char* ws = p.ws;
    const bf16_t* hbig = (const bf16_t*)(ws + WS_HBIG);
    const bf16_t* hsm = (const bf16_t*)(ws + WS_HSMALL);
    bf16_t* s_lw = (bf16_t*)(ws + WS_STREAMS);
    bf16_t* s_a = (bf16_t*)(ws + WS_STREAMS + STREAM_BYTES);
    bf16_t* s_kk = (bf16_t*)(ws + WS_STREAMS + 2 * STREAM_BYTES);
    bf16_t* s_g = (bf16_t*)(ws + WS_STREAMS + 3 * STREAM_BYTES);
    bf16_t* mq = (bf16_t*)(ws + WS_MLA + MLA_Q);
    bf16_t* mk = (bf16_t*)(ws + WS_MLA + MLA_K);
    bf16_t* mv = (bf16_t*)(ws + WS_MLA + MLA_V);
    const unsigned char* sw = ws + WS_SMALLW + l * SMALLW_LAYER;
    const bf16_t* wup_t = (const bf16_t*)(sw + SW_WUP); const bf16_t* aup_t = (const bf16_t*)(sw + SW_AUP); const bf16_t* gup_t = (const bf16_t*)(sw + SW_GUP);
    const bf16_t* uq_t = (const bf16_t*)(sw + SW_UQ); const bf16_t* ukv_t = (const bf16_t*)(sw + SW_UKV);
    const float* mu = p.mu + l * 1792;
    LAS bf16_t* A_w = (LAS bf16_t*)(lds + PA_W); LAS bf16_t* A_a = (LAS bf16_t*)(lds + PA_A); LAS bf16_t* A_g = (LAS bf16_t*)(lds + PA_G);
    LAS bf16_t* A_q = (LAS bf16_t*)(lds + PA_Q); LAS bf16_t* A_kv = (LAS bf16_t*)(lds + PA_KV);
    LAS float* rinvq = (LAS float*)(lds + PA_RQ); LAS float* rinvkv = (LAS float*)(lds + PA_RKV);
    LAS float* cosT = (LAS float*)(lds + PA_COS); LAS float* sinT = (LAS float*)(lds + PA_SIN);
    LAS float* qgL = (LAS float*)(lds + PA_QG); LAS float* kgL = (LAS float*)(lds + PA_KG);
    const int fr = lane & 15, fq = lane >> 4;

    for (int tile = blockIdx.x; tile < NTOK / 64; tile += gridDim.x) {
        const int tok0 = tile * 64, t0 = tok0 & (SEQ - 1), bidx = tok0 / SEQ;
#pragma unroll
        for (int i = 0; i < 4; ++i) {
            const int id = tid + i * NTHR, tk = id >> 5, c8 = (id & 31) * 8;
            const u32x4 cur = *(const u32x4*)(hsm + (size_t)(tok0 + tk) * HS + c8);
            u32x4 prv = {0u, 0u, 0u, 0u};
            if (t0 + tk > 0) prv = *(const u32x4*)(hsm + (size_t)(tok0 + tk - 1) * HS + c8);
            float o[8];
#pragma unroll
            for (int j = 0; j < 4; ++j) {
                o[2 * j] = shiftf(bflo(cur[j]), bflo(prv[j]), mu[1536 + c8 + 2 * j]);
                o[2 * j + 1] = shiftf(bfhi(cur[j]), bfhi(prv[j]), mu[1536 + c8 + 2 * j + 1]);
            }
            LAS bf16_t* dstp;
            if (c8 < 64) {
#pragma unroll
                for (int j = 0; j < 8; ++j) { const float e = __expf(2.f * o[j]); o[j] = 1.f - 2.f * __builtin_amdgcn_rcpf(e + 1.f); }
                dstp = A_w + tk * 72 + c8;
            } else if (c8 < 128) { dstp = A_a + tk * 72 + (c8 - 64); }
            else {
#pragma unroll
                for (int j = 0; j < 8; ++j) o[j] = sigmoidf_(o[j]);
                dstp = A_g + tk * 136 + (c8 - 128);
            }
            u32x4 w; w.x = cvt_pk_bf16(o[0], o[1]); w.y = cvt_pk_bf16(o[2], o[3]); w.z = cvt_pk_bf16(o[4], o[5]); w.w = cvt_pk_bf16(o[6], o[7]);
            *(LAS u32x4*)dstp = w;
        }
#pragma unroll
        for (int i = 0; i < 4; ++i) {
            const int tk = wave * 8 + i * 2 + (lane >> 5), c8 = (lane & 31) * 8;
            const u32x4 cur = *(const u32x4*)(hsm + (size_t)(tok0 + tk) * HS + 256 + c8);
            float s = 0.f;
#pragma unroll
            for (int j = 0; j < 4; ++j) { const float a = bflo(cur[j]), b = bfhi(cur[j]); s += a * a + b * b; }
#pragma unroll
            for (int o = 1; o < 32; o <<= 1) s += __shfl_xor(s, o);
            *(LAS u32x4*)(A_q + tk * 264 + c8) = cur;
            if ((lane & 31) == 0) rinvq[tk] = rsqrtf(s * (1.f / 256.f) + 1e-6f);
        }
#pragma unroll
        for (int i = 0; i < 2; ++i) {
            const int tk = wave * 8 + i * 4 + (lane >> 4), c8 = (lane & 15) * 8;
            const u32x4 cur = *(const u32x4*)(hsm + (size_t)(tok0 + tk) * HS + 512 + c8);
            float s = 0.f;
#pragma unroll
            for (int j = 0; j < 4; ++j) { const float a = bflo(cur[j]), b = bfhi(cur[j]); s += a * a + b * b; }
#pragma unroll
            for (int o = 1; o < 16; o <<= 1) s += __shfl_xor(s, o);
            *(LAS u32x4*)(A_kv + tk * 136 + c8) = cur;
            if ((lane & 15) == 0) rinvkv[tk] = rsqrtf(s * (1.f / 128.f) + 1e-6f);
        }
        if (tid < 96) { qgL[tid] = p.qn_g[l * 96 + tid]; kgL[tid] = p.kn_g[l * 96 + tid]; }
#pragma unroll
        for (int i = 0; i < 2; ++i) {
            const int id = tid + i * NTHR, tk = id >> 4, fi = id & 15;
            double invf = 1.0; for (int k_ = 0; k_ < fi; ++k_) invf *= 0.56234132519034908;
            const double ang = (double)p.pos[tok0 + tk] * invf;
            const double rev = ang * 0.15915494309189533577;
            const float fr_ = (float)(rev - __builtin_rint(rev));
            cosT[id] = __builtin_amdgcn_cosf(fr_); sinT[id] = __builtin_amdgcn_sinf(fr_);
        }
#pragma unroll 2
        for (int i = 0; i < 8; ++i) {
            const int tk = wave * 8 + i, c0 = lane * 8;
            const u32x4 cur = *(const u32x4*)(hbig + (size_t)(tok0 + tk) * HB + 512 + c0);
            u32x4 prv = {0u, 0u, 0u, 0u};
            if (t0 + tk > 0) prv = *(const u32x4*)(hbig + (size_t)(tok0 + tk - 1) * HB + 512 + c0);
            float o[8]; float s = 0.f;
#pragma unroll
            for (int j = 0; j < 4; ++j) {
                o[2 * j] = shiftf(bflo(cur[j]), bflo(prv[j]), mu[512 + c0 + 2 * j]) * p.k_k[l * 512 + c0 + 2 * j];
                o[2 * j + 1] = shiftf(bfhi(cur[j]), bfhi(prv[j]), mu[512 + c0 + 2 * j + 1]) * p.k_k[l * 512 + c0 + 2 * j + 1];
                s += o[2 * j] * o[2 * j] + o[2 * j + 1] * o[2 * j + 1];
            }
            s += __shfl_xor(s, 1); s += __shfl_xor(s, 2); s += __shfl_xor(s, 4);
            const float rn = rsqrtf(s + 1e-12f);
            u32x4 w; w.x = cvt_pk_bf16(o[0] * rn, o[1] * rn); w.y = cvt_pk_bf16(o[2] * rn, o[3] * rn); w.z = cvt_pk_bf16(o[4] * rn, o[5] * rn); w.w = cvt_pk_bf16(o[6] * rn, o[7] * rn);
            *(u32x4*)(s_kk + (size_t)(tok0 + tk) * 512 + c0) = w;
        }
        __syncthreads();
        lora_job<64, 0>(A_w, wup_t, s_lw, p.w0 + l * 512, tok0, wave, fr, fq);
        lora_job<64, 1>(A_a, aup_t, s_a, p.a0 + l * 512, tok0, wave, fr, fq);
        lora_job<128, 2>(A_g, gup_t, s_g, nullptr, tok0, wave, fr, fq);
#pragma unroll 1
        for (int cc = 0; cc < 2; ++cc) {
            const int combo = wave * 2 + cc, hd = combo >> 2, mt = combo & 3;
            f32x4 acc[6];
#pragma unroll
            for (int n = 0; n < 6; ++n) acc[n] = (f32x4){0.f, 0.f, 0.f, 0.f};
#pragma unroll 1
            for (int kh = 0; kh < 4; ++kh) {
                bf16x8 bfr[2][6];
#pragma unroll
                for (int k4 = 0; k4 < 2; ++k4)
#pragma unroll
                    for (int n = 0; n < 6; ++n) bfr[k4][n] = *(const bf16x8*)(uq_t + (size_t)(hd * 96 + n * 16 + fr) * 256 + (kh * 2 + k4) * 32 + fq * 8);
                __builtin_amdgcn_sched_barrier(0);
#pragma unroll
                for (int k4 = 0; k4 < 2; ++k4) {
                    const bf16x8 afr = *(const LAS bf16x8*)(A_q + (mt * 16 + fr) * 264 + (kh * 2 + k4) * 32 + fq * 8);
#pragma unroll
                    for (int n = 0; n < 6; ++n) acc[n] = __builtin_amdgcn_mfma_f32_16x16x32_bf16(afr, bfr[k4][n], acc[n], 0, 0, 0);
                }
            }
            const float qscale = 0.10206207261596575f * 1.4426950408889634f;
#pragma unroll
            for (int r = 0; r < 4; ++r) {
                const int tk = mt * 16 + fq * 4 + r; const float rq = rinvq[tk];
                float v[6]; float ss = 0.f;
#pragma unroll
                for (int n = 0; n < 6; ++n) { v[n] = acc[n][r] * rq; ss += v[n] * v[n]; }
                ss = row16_sum(ss);
                const float rh = 1.0f / sqrtf(ss * (1.f / 96.f) + 1e-6f);
#pragma unroll
                for (int n = 0; n < 6; ++n) v[n] = v[n] * rh * qgL[n * 16 + fr];
                const float c = cosT[tk * 16 + fr], s = sinT[tk * 16 + fr];
                const float x1 = v[4], x2 = v[5]; v[4] = x1 * c - x2 * s; v[5] = x1 * s + x2 * c;
                bf16_t* qo = mq + ((size_t)(bidx * 4 + hd) * SEQ + t0 + tk) * 96 + fr;
#pragma unroll
                for (int n = 0; n < 6; ++n) qo[n * 16] = f2bf(v[n] * qscale);
            }
        }
#pragma unroll 1
        for (int cc = 0; cc < 2; ++cc) {
            const int combo = wave * 2 + cc, hd = combo >> 2, mt = combo & 3;
            f32x4 acc[8];
#pragma unroll
            for (int n = 0; n < 8; ++n) acc[n] = (f32x4){0.f, 0.f, 0.f, 0.f};
#pragma unroll 1
            for (int kh = 0; kh < 2; ++kh) {
                bf16x8 bfr[2][8];
#pragma unroll
                for (int k2 = 0; k2 < 2; ++k2)
#pragma unroll
                    for (int n = 0; n < 8; ++n) bfr[k2][n] = *(const bf16x8*)(ukv_t + (size_t)(hd * 128 + n * 16 + fr) * 128 + (kh * 2 + k2) * 32 + fq * 8);
                __builtin_amdgcn_sched_barrier(0);
#pragma unroll
                for (int k2 = 0; k2 < 2; ++k2) {
                    const bf16x8 afr = *(const LAS bf16x8*)(A_kv + (mt * 16 + fr) * 136 + (kh * 2 + k2) * 32 + fq * 8);
#pragma unroll
                    for (int n = 0; n < 8; ++n) acc[n] = __builtin_amdgcn_mfma_f32_16x16x32_bf16(afr, bfr[k2][n], acc[n], 0, 0, 0);
                }
            }
#pragma unroll
            for (int r = 0; r < 4; ++r) {
                const int tk = mt * 16 + fq * 4 + r; const float rk = rinvkv[tk];
                const float kr1 = bf1(hsm[(size_t)(tok0 + tk) * HS + 640 + fr]), kr2 = bf1(hsm[(size_t)(tok0 + tk) * HS + 656 + fr]);
                float v[4]; float ss = kr1 * kr1 + kr2 * kr2;
#pragma unroll
                for (int n = 0; n < 4; ++n) { v[n] = acc[n][r] * rk; ss += v[n] * v[n]; }
                ss = row16_sum(ss);
                const float rh = 1.0f / sqrtf(ss * (1.f / 96.f) + 1e-6f);
                const float c = cosT[tk * 16 + fr], s = sinT[tk * 16 + fr];
                const float x1 = kr1 * rh * kgL[64 + fr], x2 = kr2 * rh * kgL[80 + fr];
                bf16_t* ko = mk + ((size_t)(bidx * 4 + hd) * SEQ + t0 + tk) * 96 + fr;
#pragma unroll
                for (int n = 0; n < 4; ++n) ko[n * 16] = f2bf(v[n] * rh * kgL[n * 16 + fr]);
                ko[64] = f2bf(x1 * c - x2 * s); ko[80] = f2bf(x1 * s + x2 * c);
                bf16_t* vo = mv + ((size_t)(bidx * 4 + hd) * SEQ + t0 + tk) * 64 + fr;
#pragma unroll
                for (int n = 0; n < 4; ++n) vo[n * 16] = f2bf(acc[4 + n][r] * rk);
            }
        }
        __syncthreads();
    }
}

constexpr int SC_STEPF = 336;
constexpr int SC_CH = 32;
constexpr int SC_BUF_BYTES = SC_CH * SC_STEPF * 4;
constexpr int SC_YOFF = 2 * SC_BUF_BYTES;

struct ScanRegs { unsigned rc[4], rp[4], kc[4], kp[4], av[4], kkv[4], lwv[4]; unsigned vc, vp; };
struct ScanConst { float mur0, mur1, muk0, muk1, ka0, ka1, muv0, muv1; };
__device__ __forceinline__ void scan_load(const Params& p, ScanRegs& R, int b, int h, int rq, int chunk, int lt) {
    const unsigned char* ws = p.ws;
    const bf16_t* hbig = (const bf16_t*)(ws + WS_HBIG);
    const bf16_t* s_lw = (const bf16_t*)(ws + WS_STREAMS);
    const bf16_t* s_a = (const bf16_t*)(ws + WS_STREAMS + STREAM_BYTES);
    const bf16_t* s_kk = (const bf16_t*)(ws + WS_STREAMS + 2 * STREAM_BYTES);
    const int jp = lt & 31, c = h * 64 + 2 * jp;
#pragma unroll
    for (int i = 0; i < 4; ++i) {
        const int s = (lt >> 5) + 8 * i, t = chunk * SC_CH + s; const size_t tok = (size_t)b * SEQ + t;
        R.rc[i] = *(const unsigned*)(hbig + tok * HB + c); R.kc[i] = *(const unsigned*)(hbig + tok * HB + 512 + c);
        R.rp[i] = 0u; R.kp[i] = 0u;
        if (t > 0) { R.rp[i] = *(const unsigned*)(hbig + (tok - 1) * HB + c); R.kp[i] = *(const unsigned*)(hbig + (tok - 1) * HB + 512 + c); }
        R.av[i] = *(const unsigned*)(s_a + tok * 512 + c); R.kkv[i] = *(const unsigned*)(s_kk + tok * 512 + c); R.lwv[i] = *(const unsigned*)(s_lw + tok * 512 + c);
    }
    {
        const int s = lt >> 3, ip = lt & 7, t = chunk * SC_CH + s, cv = h * 64 + rq * 16 + 2 * ip; const size_t tok = (size_t)b * SEQ + t;
        R.vc = *(const unsigned*)(hbig + tok * HB + 1024 + cv);
        R.vp = 0u; if (t > 0) R.vp = *(const unsigned*)(hbig + (tok - 1) * HB + 1024 + cv);
    }
}
__device__ __forceinline__ void scan_write(const ScanRegs& R, const ScanConst& C, LAS float* buf, int lt) {
    const int jp = lt & 31;
#pragma unroll
    for (int i = 0; i < 4; ++i) {
        const int s = (lt >> 5) + 8 * i;
        const float a0 = bflo(R.av[i]), a1 = bfhi(R.av[i]), kk0 = bflo(R.kkv[i]), kk1 = bfhi(R.kkv[i]);
        LAS float* o = buf + s * SC_STEPF + 2 * jp;
        *(LAS f32x2*)(o) = (f32x2){-kk0, -kk1};
        *(LAS f32x2*)(o + 64) = (f32x2){__expf(bflo(R.lwv[i])), __expf(bfhi(R.lwv[i]))};
        *(LAS f32x2*)(o + 128) = (f32x2){kk0 * a0, kk1 * a1};
        const float ks0 = shiftf(bflo(R.kc[i]), bflo(R.kp[i]), C.muk0), ks1 = shiftf(bfhi(R.kc[i]), bfhi(R.kp[i]), C.muk1);
        *(LAS f32x2*)(o + 192) = (f32x2){ks0 * (1.f + (a0 - 1.f) * C.ka0), ks1 * (1.f + (a1 - 1.f) * C.ka1)};
        *(LAS f32x2*)(o + 256) = (f32x2){shiftf(bflo(R.rc[i]), bflo(R.rp[i]), C.mur0), shiftf(bfhi(R.rc[i]), bfhi(R.rp[i]), C.mur1)};
    }
    {
        const int s = lt >> 3, ip = lt & 7;
        *(LAS f32x2*)(buf + s * SC_STEPF + 320 + 2 * ip) = (f32x2){shiftf(bflo(R.vc), bflo(R.vp), C.muv0), shiftf(bfhi(R.vc), bfhi(R.vp), C.muv1)};
    }
}
__device__ __forceinline__ void scan_flush(const Params& p, const LAS float* yb, int b, int h, int rq, int chunk, int lt) {
    bf16_t* mixed = (bf16_t*)(p.ws + WS_MIXED);
#pragma unroll
    for (int j = 0; j < 2; ++j) {
        const int id = lt + 256 * j, s = id >> 4, row = id & 15, t = chunk * SC_CH + s; const size_t tok = (size_t)b * SEQ + t;
        const f32x4 q = *(const LAS f32x4*)(yb + id * 8), q2 = *(const LAS f32x4*)(yb + id * 8 + 4);
        mixed[tok * 1024 + h * 64 + rq * 16 + row] = f2bf(((q[0] + q[1]) + (q[2] + q[3])) + ((q2[0] + q2[1]) + (q2[2] + q2[3])));
    }
}
struct StepOps { f32x4 na, w, bb, kk, r; float v; };
#define SC_LD(X, s_) do { const LAS float* vb_ = cur + (s_) * SC_STEPF; X.na = *(const LAS f32x4*)(vb_ + c4); X.w = *(const LAS f32x4*)(vb_ + 64 + c4); \
        X.bb = *(const LAS f32x4*)(vb_ + 128 + c4); X.kk = *(const LAS f32x4*)(vb_ + 192 + c4); X.r = *(const LAS f32x4*)(vb_ + 256 + c4); X.v = vb_[320 + row]; } while (0)
#define SC_STEP(X, s_) do { \
        float sa = (S0 * X.na[0] + S2 * X.na[2]) + (S1 * X.na[1] + S3 * X.na[3]); \
        const float u0 = S0 * X.w[0] + X.v * X.kk[0], u1 = S1 * X.w[1] + X.v * X.kk[1], u2 = S2 * X.w[2] + X.v * X.kk[2], u3 = S3 * X.w[3] + X.v * X.kk[3]; \
        sa = row16_sum(sa); \
        S0 = u0 + sa * X.bb[0]; S1 = u1 + sa * X.bb[1]; S2 = u2 + sa * X.bb[2]; S3 = u3 + sa * X.bb[3]; \
        float y = (S0 * X.r[0] + S2 * X.r[2]) + (S1 * X.r[1] + S3 * X.r[3]); \
        y = DPP_ROR_ADD(y, 8); yp[(s_) * 128] = y; } while (0)
__device__ __forceinline__ void scan_unit(const Params& p, int l, LAS unsigned char* lds, int unit) {
    int tid_ = threadIdx.x; asm volatile("" : "+v"(tid_)); const int tid = tid_, lane = tid & 63, wave = tid >> 6;
    const int rq = unit & 3, h = (unit >> 2) & 7, b = unit >> 5;
    LAS float* buf0 = (LAS float*)lds; LAS float* buf1 = (LAS float*)(lds + SC_BUF_BYTES);
    LAS float* yb0 = (LAS float*)(lds + SC_YOFF); LAS float* yb1 = yb0 + SC_CH * 128;
    LAS float* ydummy = (LAS float*)(lds + SC_YOFF + 2 * SC_CH * 128 * 4);
    const bool loader = wave >= 4; const int lt = tid & 255;
    constexpr int NCH = SEQ / SC_CH;
    ScanRegs R; ScanConst C;
    {
        const float* mu = p.mu + l * 1792; const int c = h * 64 + 2 * (lt & 31), cv = h * 64 + rq * 16 + 2 * (lt & 7);
        C.mur0 = mu[c]; C.mur1 = mu[c + 1]; C.muk0 = mu[512 + c]; C.muk1 = mu[512 + c + 1];
        C.ka0 = p.k_a[l * 512 + c]; C.ka1 = p.k_a[l * 512 + c + 1]; C.muv0 = mu[1024 + cv]; C.muv1 = mu[1024 + cv + 1];
    }
    if (loader) { scan_load(p, R, b, h, rq, 0, lt); scan_write(R, C, buf0, lt); scan_load(p, R, b, h, rq, 1, lt); }
    __syncthreads();
    float S0 = 0.f, S1 = 0.f, S2 = 0.f, S3 = 0.f;
    const int row = (wave & 3) * 4 + (lane >> 4), c4 = (lane & 15) * 4;
    for (int ch = 0; ch < NCH; ++ch) {
        const int par = ch & 1;
        LAS float* cur = buf0 + par * (SC_BUF_BYTES / 4); LAS float* nxt = buf0 + (par ^ 1) * (SC_BUF_BYTES / 4);
        LAS float* ycur = yb0 + par * (SC_CH * 128); LAS float* yprev = yb0 + (par ^ 1) * (SC_CH * 128);
        if (loader) {
            if (ch + 1 < NCH) scan_write(R, C, nxt, lt);
            if (ch + 2 < NCH) scan_load(p, R, b, h, rq, ch + 2, lt);
            if (ch > 0) scan_flush(p, yprev, b, h, rq, ch - 1, lt);
        } else {
            LAS float* yp = ((lane & 15) < 8) ? (ycur + row * 8 + (lane & 15)) : (ydummy + lane);
            StepOps A, B, Cc;
            SC_LD(A, 0); SC_LD(B, 1);
#pragma unroll
            for (int s = 0; s < SC_CH; s += 3) {
                if (s + 2 < SC_CH) SC_LD(Cc, s + 2);
                SC_STEP(A, s);
                if (s + 3 < SC_CH) SC_LD(A, s + 3);
                if (s + 1 < SC_CH) SC_STEP(B, s + 1);
                if (s + 4 < SC_CH) SC_LD(B, s + 4);
                if (s + 2 < SC_CH) SC_STEP(Cc, s + 2);
            }
        }
        LDS_BARRIER();
    }
    if (loader) scan_flush(p, yb1, b, h, rq, NCH - 1, lt);
    __syncthreads();
}

template <int DQK, bool SBK>
__device__ __forceinline__ void attn_unit(LAS unsigned char* lds, const bf16_t* Q, const bf16_t* K, const bf16_t* V, int ldq, int ldk, int ldv, bf16_t* O, int qb) {
    constexpr int KSTR = DQK + 8;
    constexpr int VSTR = 68;
    constexpr int NKS = DQK / 16, KCH = DQK / 8;
    LAS bf16_t* Ks = (LAS bf16_t*)lds; LAS bf16_t* Vt = (LAS bf16_t*)(lds + 64 * KSTR * 2);
    int tid_ = threadIdx.x; asm volatile("" : "+v"(tid_)); const int tid = tid_, lane = tid & 63, wave = tid >> 6, l31 = lane & 31, hh = lane >> 5;
    const int q0 = qb * 256 + wave * 32, tq = q0 + l31, qchunk = q0 >> 6;
    bf16x8 qf[NKS];
#pragma unroll
    for (int ks = 0; ks < NKS; ++ks) qf[ks] = *(const bf16x8*)(Q + (size_t)tq * ldq + ks * 16 + hh * 8);
    f32x16 o0, o1;
#pragma unroll
    for (int i = 0; i < 16; ++i) { o0[i] = 0.f; o1[i] = 0.f; }
    float m_run = -1e30f, l_run = 0.f, R = 0.f;
    bool wdone = false;
    volatile LAS int* dflags = (volatile LAS int*)(lds + 64 * KSTR * 2 + 64 * VSTR * 2);
    const int ntiles = 4 * qb + 4;
    const int kr0 = tid / KCH, kc0 = tid % KCH, kr1 = (tid + NTHR) / KCH, kc1 = (tid + NTHR) % KCH;
    const bool two = (64 * KCH > NTHR) && (tid + NTHR < 64 * KCH);
    const int vr = tid >> 3, vc = tid & 7;
    u32x4 kreg0, kreg1 = {0u, 0u, 0u, 0u}, vreg;
    int kt = SBK ? ntiles - 1 : 0;
    kreg0 = *(const u32x4*)(K + (size_t)(kt * 64 + kr0) * ldk + kc0 * 8);
    if (two) kreg1 = *(const u32x4*)(K + (size_t)(kt * 64 + kr1) * ldk + kc1 * 8);
    vreg = *(const u32x4*)(V + (size_t)(kt * 64 + vr) * ldv + vc * 8);
    for (int it = 0; it < ntiles; ++it) {
        *(LAS u32x4*)(Ks + kr0 * KSTR + kc0 * 8) = kreg0;
        if (two) *(LAS u32x4*)(Ks + kr1 * KSTR + kc1 * 8) = kreg1;
#pragma unroll
        for (int j = 0; j < 4; ++j) {
            Vt[(vc * 8 + 2 * j) * VSTR + vr] = (bf16_t)(vreg[j] & 0xffffu);
            Vt[(vc * 8 + 2 * j + 1) * VSTR + vr] = (bf16_t)(vreg[j] >> 16);
        }
        __syncthreads();
        const int ktn = SBK ? kt - 1 : kt + 1;
        if (it + 1 < ntiles) {
            kreg0 = *(const u32x4*)(K + (size_t)(ktn * 64 + kr0) * ldk + kc0 * 8);
            if (two) kreg1 = *(const u32x4*)(K + (size_t)(ktn * 64 + kr1) * ldk + kc1 * 8);
            vreg = *(const u32x4*)(V + (size_t)(ktn * 64 + vr) * ldv + vc * 8);
        }
        if (kt <= qchunk && !wdone) {
            f32x16 p0, p1;
#pragma unroll
            for (int i = 0; i < 16; ++i) { p0[i] = 0.f; p1[i] = 0.f; }
#pragma unroll
            for (int ks = 0; ks < NKS; ++ks) {
                const bf16x8 k0f = *(const LAS bf16x8*)(Ks + l31 * KSTR + ks * 16 + hh * 8);
                const bf16x8 k1f = *(const LAS bf16x8*)(Ks + (32 + l31) * KSTR + ks * 16 + hh * 8);
                p0 = __builtin_amdgcn_mfma_f32_32x32x16_bf16(k0f, qf[ks], p0, 0, 0, 0);
                p1 = __builtin_amdgcn_mfma_f32_32x32x16_bf16(k1f, qf[ks], p1, 0, 0, 0);
            }
            if (!SBK) {
                float mx = p0[0];
#pragma unroll
                for (int i = 1; i < 16; ++i) mx = fmaxf(mx, p0[i]);
#pragma unroll
                for (int i = 0; i < 16; ++i) mx = fmaxf(mx, p1[i]);
                mx = fmaxf(mx, __shfl_xor(mx, 32));
                const float m_new = fmaxf(m_run, mx), alpha = __builtin_amdgcn_exp2f(m_run - m_new);
                m_run = m_new; l_run *= alpha;
#pragma unroll
                for (int i = 0; i < 16; ++i) { o0[i] *= alpha; o1[i] *= alpha; }
                float ls = 0.f;
#pragma unroll
                for (int i = 0; i < 16; ++i) { p0[i] = __builtin_amdgcn_exp2f(p0[i] - m_new); p1[i] = __builtin_amdgcn_exp2f(p1[i] - m_new); ls += p0[i] + p1[i]; }
                l_run += ls;
            } else {
                const bool diag = (kt == qchunk);
#pragma unroll
                for (int half = 1; half >= 0; --half) {
                    f32x16& pp = half ? p1 : p0;
                    const int kbase = kt * 64 + half * 32 + 4 * hh;
                    float z[16], ls[16];
#pragma unroll
                    for (int i = 0; i < 16; ++i) {
                        z[i] = pp[i] * 0.125f;
                        const bool valid = !diag || (kbase + (i & 3) + 8 * (i >> 2) < tq);
                        ls[i] = valid ? -softplusf_(z[i]) : 0.f;
                        if (!valid) z[i] = -1e30f;
                    }
                    float g[4], og[4];
#pragma unroll
                    for (int i = 0; i < 4; ++i) { g[i] = (ls[4 * i] + ls[4 * i + 1]) + (ls[4 * i + 2] + ls[4 * i + 3]); og[i] = __shfl_xor(g[i], 32); }
                    float tail = 0.f;
#pragma unroll
                    for (int i = 3; i >= 0; --i) {
                        float run = R + tail + (hh == 0 ? og[i] : 0.f);
#pragma unroll
                        for (int r = 3; r >= 0; --r) { run += ls[4 * i + r]; pp[4 * i + r] = __expf(z[4 * i + r] + run); }
                        tail += g[i] + og[i];
                    }
                    R += tail;
                }
            }
#pragma unroll
            for (int half = 0; half < 2; ++half) {
                const f32x16& pp = half ? p1 : p0;
#pragma unroll
                for (int s = 0; s < 2; ++s) {
                    u32x4 pw; pw.x = cvt_pk_bf16(pp[8 * s + 0], pp[8 * s + 1]); pw.y = cvt_pk_bf16(pp[8 * s + 2], pp[8 * s + 3]);
                    pw.z = cvt_pk_bf16(pp[8 * s + 4], pp[8 * s + 5]); pw.w = cvt_pk_bf16(pp[8 * s + 6], pp[8 * s + 7]);
                    const bf16x8 pf = __builtin_bit_cast(bf16x8, pw);
                    const int koff = half * 32 + 16 * s + 4 * hh;
                    u32x4 va, vb;
                    const u32x2 a0 = *(const LAS u32x2*)(Vt + l31 * VSTR + koff), a1 = *(const LAS u32x2*)(Vt + l31 * VSTR + koff + 8);
                    const u32x2 b0 = *(const LAS u32x2*)(Vt + (32 + l31) * VSTR + koff), b1 = *(const LAS u32x2*)(Vt + (32 + l31) * VSTR + koff + 8);
                    va.x = a0.x; va.y = a0.y; va.z = a1.x; va.w = a1.y; vb.x = b0.x; vb.y = b0.y; vb.z = b1.x; vb.w = b1.y;
                    o0 = __builtin_amdgcn_mfma_f32_32x32x16_bf16(__builtin_bit_cast(bf16x8, va), pf, o0, 0, 0, 0);
                    o1 = __builtin_amdgcn_mfma_f32_32x32x16_bf16(__builtin_bit_cast(bf16x8, vb), pf, o1, 0, 0, 0);
                }
            }
        }
        if (SBK) {
            if (kt <= qchunk && !wdone) wdone = __all(R < -45.f);
            if (lane == 0) dflags[wave] = wdone ? 1 : 0;
        }
        __syncthreads();
        if (SBK) {
            int alld = 1;
#pragma unroll
            for (int w = 0; w < 8; ++w) alld &= dflags[w];
            if (alld) break;
        }
        kt = ktn;
    }
    float inv = 1.f;
    if (!SBK) { const float lt = l_run + __shfl_xor(l_run, 32); inv = 1.f / lt; }
    bf16_t* orow = O + (size_t)tq * 1024;
#pragma unroll
    for (int i = 0; i < 4; ++i) {
        u32x2 w0, w1;
        w0.x = cvt_pk_bf16(o0[4 * i] * inv, o0[4 * i + 1] * inv); w0.y = cvt_pk_bf16(o0[4 * i + 2] * inv, o0[4 * i + 3] * inv);
        w1.x = cvt_pk_bf16(o1[4 * i] * inv, o1[4 * i + 1] * inv); w1.y = cvt_pk_bf16(o1[4 * i + 2] * inv, o1[4 * i + 3] * inv);
        *(u32x2*)(orow + 8 * i + 4 * hh) = w0;
        *(u32x2*)(orow + 32 + 8 * i + 4 * hh) = w1;
    }
}

__device__ __forceinline__ void conv_item(const Params& p, int l, LAS unsigned char* lds, int part, int nparts) {
    int tid_ = threadIdx.x; asm volatile("" : "+v"(tid_)); const int tid = tid_, lane = tid & 63, wave = tid >> 6;
    const int gw = part * 8 + wave, ngw = nparts * 8;
    unsigned char* ws = p.ws;
    LAS float* scr = (LAS float*)(lds + wave * 8448);
    conv_run(p.w_o + (size_t)l * 1024 * 1024, nullptr, nullptr, (bf16_t*)(ws + WS_WO), 1024, 1024, 1024, 0, scr, gw, ngw, lane);
    conv_run(p.w_gate + (size_t)l * 1024 * FF, p.w_upf + (size_t)l * 1024 * FF, p.ffn_g + l * 1024, (bf16_t*)(ws + WS_WGU), 1024, FF, 2 * FF, 2, scr, gw, ngw, lane);
    conv_run(p.w_down + (size_t)l * FF * 1024, nullptr, nullptr, (bf16_t*)(ws + WS_WDN), FF, 1024, 1024, 0, scr, gw, ngw, lane);
    if (l + 1 < DEPTH) conv_run(p.w_in + (size_t)(l + 1) * 1024 * INC, nullptr, p.attn_norm_g + (l + 1) * 1024, (bf16_t*)(ws + WS_WIN), 1024, INC, 3072, 1, scr, gw, ngw, lane);
    __syncthreads();
}
__device__ __forceinline__ void phase_mixer(const Params& p, int l, LAS unsigned char* lds) {
    unsigned char* ws = p.ws;
    unsigned* ctr = (unsigned*)(ws + WS_CTR) + l;
    volatile LAS int* s_item = (volatile LAS int*)(lds + LDS_ITEM_OFF);
    const bf16_t* hbig = (const bf16_t*)(ws + WS_HBIG);
    bf16_t* mixed = (bf16_t*)(ws + WS_MIXED);
    for (;;) {
        if (threadIdx.x == 0) *s_item = (int)atomicAdd(ctr, 1u);
        __syncthreads();
        const int item = *s_item;
        __syncthreads();
        if (item >= P2_ITEMS) break;
        if (item < 128) {
#ifndef SKIP_SCAN
            scan_unit(p, l, lds, item);
#endif
            continue; }
#ifdef SKIP_ATTN
        continue;
#endif
        if (item >= 640) { conv_item(p, l, lds, item - 640, P2_CONV); continue; }
        const int a = item - 128, qb = 15 - (a >> 5), kind = (a >> 4) & 1, bh = a & 15, b = bh >> 2, hd = bh & 3;
        if (kind == 0) {
            const bf16_t* base = hbig + (size_t)b * SEQ * HB + hd * 64;
#ifndef SKIP_SB
            attn_unit<64, true>(lds, base + 1536, base + 1792, base + 2048, HB, HB, HB, mixed + (size_t)b * SEQ * 1024 + 768 + hd * 64, qb);
#endif
        } else {
            const bf16_t* q = (const bf16_t*)(ws + WS_MLA + MLA_Q) + (size_t)bh * SEQ * 96;
            const bf16_t* k = (const bf16_t*)(ws + WS_MLA + MLA_K) + (size_t)bh * SEQ * 96;
            const bf16_t* v = (const bf16_t*)(ws + WS_MLA + MLA_V) + (size_t)bh * SEQ * 64;
#ifdef FAKE_MLA
            { bf16_t* O = mixed + (size_t)b * SEQ * 1024 + 512 + hd * 64;
              for (int e = threadIdx.x; e < 256 * 64; e += NTHR) { const int tq = qb * 256 + (e >> 6), dv = e & 63;
                const float val = bf1(v[(size_t)tq * 64 + dv]) + bf1(q[(size_t)tq * 96 + dv]) + bf1(q[(size_t)tq * 96 + dv + 32]) + bf1(k[(size_t)tq * 96 + dv]) + bf1(k[(size_t)tq * 96 + dv + 32]);
                O[(size_t)tq * 1024 + dv] = f2bf(val); } }
#elif !defined(SKIP_MLA)
            attn_unit<96, false>(lds, q, k, v, 96, 96, 64, mixed + (size_t)b * SEQ * 1024 + 512 + hd * 64, qb);
#endif
        }
    }
}

__device__ __forceinline__ void phase_finalize(const Params& p, int l) {
    int tid_ = threadIdx.x; asm volatile("" : "+v"(tid_)); const int tid = tid_, lane = tid & 63, wave = tid >> 6;
    const int gw = blockIdx.x * 8 + wave, ngw = gridDim.x * 8;
    unsigned char* ws = p.ws;
    const bf16_t* hbig = (const bf16_t*)(ws + WS_HBIG);
    const bf16_t* s_a = (const bf16_t*)(ws + WS_STREAMS + STREAM_BYTES);
    const bf16_t* s_g = (const bf16_t*)(ws + WS_STREAMS + 3 * STREAM_BYTES);
    bf16_t* mixed = (bf16_t*)(ws + WS_MIXED);
    const float* mu = p.mu + l * 1792;
    const int c0 = lane * 8;
#pragma unroll 2
    for (int tok = gw; tok < NTOK; tok += ngw) {
        const int t = tok & (SEQ - 1);
        const u32x4 yv = *(const u32x4*)(mixed + (size_t)tok * 1024 + c0);
        float y[8];
#pragma unroll
        for (int j = 0; j < 4; ++j) { y[2 * j] = bflo(yv[j]); y[2 * j + 1] = bfhi(yv[j]); }
        float s = 0.f;
#pragma unroll
        for (int j = 0; j < 8; ++j) s += y[j];
        s += __shfl_xor(s, 1); s += __shfl_xor(s, 2); s += __shfl_xor(s, 4);
        const float mean = s * (1.f / 64.f);
        float q = 0.f;
#pragma unroll
        for (int j = 0; j < 8; ++j) { y[j] -= mean; q += y[j] * y[j]; }
        q += __shfl_xor(q, 1); q += __shfl_xor(q, 2); q += __shfl_xor(q, 4);
        const float rstd = rsqrtf(q * (1.f / 64.f) + 64e-5f);
        const bf16_t* hr = hbig + (size_t)tok * HB + c0;
        const u32x4 rc = *(const u32x4*)(hr), kc = *(const u32x4*)(hr + 512), vc = *(const u32x4*)(hr + 1024);
        u32x4 rp = {0u, 0u, 0u, 0u}, kp = rp, vp = rp;
        if (t > 0) { rp = *(const u32x4*)(hr - HB); kp = *(const u32x4*)(hr - HB + 512); vp = *(const u32x4*)(hr - HB + 1024); }
        const u32x4 av = *(const u32x4*)(s_a + (size_t)tok * 512 + c0), gv = *(const u32x4*)(s_g + (size_t)tok * 512 + c0);
        float vv[8], gg[8]; float bs = 0.f;
#pragma unroll
        for (int j = 0; j < 8; ++j) {
            const int w = j >> 1; const bool hi = j & 1; const int c = c0 + j;
            const float r_ = shiftf(hi ? bfhi(rc[w]) : bflo(rc[w]), hi ? bfhi(rp[w]) : bflo(rp[w]), mu[c]);
            const float ks = shiftf(hi ? bfhi(kc[w]) : bflo(kc[w]), hi ? bfhi(kp[w]) : bflo(kp[w]), mu[512 + c]);
            vv[j] = shiftf(hi ? bfhi(vc[w]) : bflo(vc[w]), hi ? bfhi(vp[w]) : bflo(vp[w]), mu[1024 + c]);
            const float a_ = hi ? bfhi(av[w]) : bflo(av[w]);
            gg[j] = hi ? bfhi(gv[w]) : bflo(gv[w]);
            const float k_ = ks * (1.f + (a_ - 1.f) * p.k_a[l * 512 + c]);
            bs += r_ * k_ * p.r_k[l * 512 + c];
        }
        bs += __shfl_xor(bs, 1); bs += __shfl_xor(bs, 2); bs += __shfl_xor(bs, 4);
        float o[8];
#pragma unroll
        for (int j = 0; j < 8; ++j) o[j] = (y[j] * rstd * p.ln_g[l * 512 + c0 + j] + p.ln_b[l * 512 + c0 + j] + bs * vv[j]) * gg[j];
        u32x4 w; w.x = cvt_pk_bf16(o[0], o[1]); w.y = cvt_pk_bf16(o[2], o[3]); w.z = cvt_pk_bf16(o[4], o[5]); w.w = cvt_pk_bf16(o[6], o[7]);
        *(u32x4*)(mixed + (size_t)tok * 1024 + c0) = w;
    }
}


__device__ __forceinline__ void grid_barrier(unsigned char* ws, unsigned& epoch) {
    asm volatile("s_waitcnt vmcnt(0) lgkmcnt(0)" ::: "memory");
    __syncthreads();
    if (threadIdx.x == 0) {
        __builtin_amdgcn_fence(__ATOMIC_RELEASE, "agent");
        unsigned* base = (unsigned*)(ws + WS_BAR);
        const unsigned q = blockIdx.x >> 2, j = q >> 3, g = blockIdx.x & 7u;
        const unsigned o1 = __hip_atomic_fetch_add(base + 64 * (1 + q), 1u, __ATOMIC_RELAXED, __HIP_MEMORY_SCOPE_AGENT);
        if (o1 == epoch * 4u + 3u) {
            const unsigned o2 = __hip_atomic_fetch_add(base + 64 * (65 + j), 1u, __ATOMIC_RELAXED, __HIP_MEMORY_SCOPE_AGENT);
            if (o2 == epoch * 8u + 7u) {
                const unsigned t = __hip_atomic_fetch_add(base + 64 * 73, 1u, __ATOMIC_RELAXED, __HIP_MEMORY_SCOPE_AGENT);
                if (t == epoch * 8u + 7u) {
#pragma unroll
                    for (unsigned r = 0; r < 8u; ++r) __hip_atomic_store(base + 64 * (74 + r), epoch + 1u, __ATOMIC_RELAXED, __HIP_MEMORY_SCOPE_AGENT);
                }
            }
        }
        while (__hip_atomic_load(base + 64 * (74 + g), __ATOMIC_RELAXED, __HIP_MEMORY_SCOPE_AGENT) < epoch + 1u) __builtin_amdgcn_s_sleep(1);
        __builtin_amdgcn_fence(__ATOMIC_ACQUIRE, "agent");
    }
    __syncthreads();
    ++epoch;
}
__global__ void __launch_bounds__(NTHR, 2) fwd_megakernel(Params p) {
    extern __shared__ __attribute__((aligned(16))) unsigned char lds_raw[];
    LAS unsigned char* lds = (LAS unsigned char*)lds_raw;
    cg::grid_group grid = cg::this_grid();
    unsigned char* ws = p.ws;
    unsigned long long* ssq = (unsigned long long*)(ws + WS_SSQ64);
    bf16_t* xb = (bf16_t*)(ws + WS_XB);
    const int G = gridDim.x, bid = blockIdx.x;
    int ph = 0; unsigned bar_epoch = 0u;
#define PHASE_BEGIN if (ph >= p.ph_lo && ph < p.ph_hi) {
#define PHASE_END   if (ph + 1 < p.ph_hi) { if (ph == 0) { asm volatile("s_waitcnt vmcnt(0)" ::: "memory"); grid.sync(); } else grid_barrier(ws, bar_epoch); } } ++ph;

    PHASE_BEGIN phase_prologue(p, lds); PHASE_END
    for (int l = 0; l < DEPTH; ++l) {
        PHASE_BEGIN
            pg8::Gemm g{xb, (const bf16_t*)(ws + WS_WIN), NTOK, 3072, 1024}; pg8::StaticOrder S; S.init(NTOK, 3072, G, bid);
            EpiH E{(bf16_t*)(ws + WS_HBIG), (bf16_t*)(ws + WS_HSMALL), ssq + (size_t)(2 * l) * NTOK};
            pg8::gemm_phase<EpiH, pg8::StaticOrder, true, true>(lds, g, S, E);
        PHASE_END
        PHASE_BEGIN
#if defined(SKIP_SCAN) || defined(SKIP_ATTN) || defined(SKIP_MLA) || defined(SKIP_SB)
        { u32x4 z = {0u,0u,0u,0u}; u32x4* mz = (u32x4*)(ws + WS_MIXED); for (size_t i = (size_t)blockIdx.x * NTHR + threadIdx.x; i < (size_t)NTOK * 1024 * 2 / 16; i += (size_t)gridDim.x * NTHR) mz[i] = z; }
#endif
        phase_prep(p, l, lds); PHASE_END
#ifdef SKIP_P2
        PHASE_BEGIN { u32x4 z = {0u,0u,0u,0u}; u32x4* mz = (u32x4*)(ws + WS_MIXED); for (size_t i = (size_t)blockIdx.x * NTHR + threadIdx.x; i < (size_t)NTOK * 1024 * 2 / 16; i += (size_t)gridDim.x * NTHR) mz[i] = z; } PHASE_END
#else
        PHASE_BEGIN phase_mixer(p, l, lds); PHASE_END
#endif
        PHASE_BEGIN phase_finalize(p, l); PHASE_END
        PHASE_BEGIN
            pg8::Gemm g{(const bf16_t*)(ws + WS_MIXED), (const bf16_t*)(ws + WS_WO), NTOK, 1024, 1024}; pg8::StaticOrder S; S.init(NTOK, 1024, G, bid);
            EpiRes E{l == 0 ? p.x : p.out, p.out, xb, ssq + (size_t)(2 * l + 1) * NTOK};
            pg8::gemm_phase<EpiRes, pg8::StaticOrder, true, true>(lds, g, S, E);
        PHASE_END
        PHASE_BEGIN
            pg8::Gemm g{xb, (const bf16_t*)(ws + WS_WGU), NTOK, 2 * FF, 1024}; pg8::StaticOrder S; S.init(NTOK, 2 * FF, G, bid);
            EpiGLU E{(bf16_t*)(ws + WS_ACT), ssq + (size_t)(2 * l + 1) * NTOK};
            pg8::gemm_phase<EpiGLU, pg8::StaticOrder, true, true>(lds, g, S, E);
        PHASE_END
        PHASE_BEGIN
            pg8::Gemm g{(const bf16_t*)(ws + WS_ACT), (const bf16_t*)(ws + WS_WDN), NTOK, 1024, FF}; pg8::StaticOrder S; S.init(NTOK, 1024, G, bid);
            EpiRes E{p.out, p.out, xb, ssq + (size_t)(2 * l + 2) * NTOK};
            pg8::gemm_phase<EpiRes, pg8::StaticOrder, true, true>(lds, g, S, E);
        PHASE_END
    }
}
constexpr int N_PHASES = 1 + 7 * DEPTH;

#ifndef MK_MULTI
#define MK_MULTI 0
#endif
extern "C" void kernel_launch(void* const* d_in, const int* in_sizes, int n_in, void* d_out, int out_size, void* d_ws, size_t ws_size, hipStream_t stream) {
    static int grid = 0;
    if (grid == 0) {
        if (n_in != 26 || ws_size < WS_END) { fprintf(stderr, "kernel_launch: unexpected inputs (n_in %d, ws %zu)\n", n_in, ws_size); grid = -1; return; }
        if (hipFuncSetAttribute((const void*)fwd_megakernel, hipFuncAttributeMaxDynamicSharedMemorySize, LDS_BYTES) != hipSuccess) { fprintf(stderr, "hipFuncSetAttribute failed\n"); grid = -1; return; }
        int dev = 0, cus = 0, per_cu = 0;
        hipGetDevice(&dev); hipDeviceGetAttribute(&cus, hipDeviceAttributeMultiprocessorCount, dev);
        hipOccupancyMaxActiveBlocksPerMultiprocessor(&per_cu, (const void*)fwd_megakernel, NTHR, LDS_BYTES);
        (void)hipGetLastError();
        if (per_cu < 1) fprintf(stderr, "occupancy query says %d blocks/CU\n", per_cu);
        grid = cus > 0 ? cus : 256;
    }
    if (grid < 0) return;
    Params p{};
    p.x = (const float*)d_in[0]; p.pos = (const int*)d_in[1]; p.attn_norm_g = (const float*)d_in[2]; p.w_in = (const float*)d_in[3];
    p.mu = (const float*)d_in[4]; p.w_up = (const float*)d_in[5]; p.w0 = (const float*)d_in[6]; p.a_up = (const float*)d_in[7];
    p.a0 = (const float*)d_in[8]; p.g_up = (const float*)d_in[9]; p.k_k = (const float*)d_in[10]; p.k_a = (const float*)d_in[11];
    p.r_k = (const float*)d_in[12]; p.ln_g = (const float*)d_in[13]; p.ln_b = (const float*)d_in[14]; p.cq_g = (const float*)d_in[15];
    p.ckv_g = (const float*)d_in[16]; p.w_uq = (const float*)d_in[17]; p.w_ukv = (const float*)d_in[18]; p.qn_g = (const float*)d_in[19];
    p.kn_g = (const float*)d_in[20]; p.w_o = (const float*)d_in[21]; p.ffn_g = (const float*)d_in[22]; p.w_gate = (const float*)d_in[23];
    p.w_upf = (const float*)d_in[24]; p.w_down = (const float*)d_in[25];
    p.out = (float*)d_out; p.ws = (unsigned char*)d_ws;
#if MK_MULTI
    for (int ph = 0; ph < N_PHASES; ++ph) {
        p.ph_lo = ph; p.ph_hi = ph + 1;
        hipLaunchKernelGGL(fwd_megakernel, dim3(grid), dim3(NTHR), LDS_BYTES, stream, p);
    }
#else
    p.ph_lo = 0; p.ph_hi = N_PHASES;
    if (hipMemsetAsync((unsigned char*)d_ws + WS_BAR, 0, 24576, stream) != hipSuccess) { fprintf(stderr, "memset of barrier words failed\n"); return; }
    void* args[] = {&p};
    hipError_t e = hipLaunchCooperativeKernel((const void*)fwd_megakernel, dim3(grid), dim3(NTHR), args, LDS_BYTES, stream);
    if (e != hipSuccess) fprintf(stderr, "cooperative launch failed: %s (grid %d)\n", hipGetErrorString(e), grid);
#endif
}
```

```cpp
#include <hip/hip_runtime.h>
#include <hip/hip_cooperative_groups.h>
#include <cstdio>
#include <cstdint>
namespace cg = cooperative_groups;

#define LAS __attribute__((address_space(3)))
typedef float f32x16 __attribute__((ext_vector_type(16)));
typedef float f32x2 __attribute__((ext_vector_type(2)));
typedef unsigned u32x2 __attribute__((ext_vector_type(2)));
typedef short s16x4 __attribute__((ext_vector_type(4)));
namespace pg8 {
#define PG8_LAS __attribute__((address_space(3)))
typedef unsigned short bf16_t;
typedef short bf16x8 __attribute__((ext_vector_type(8)));
typedef float f32x4 __attribute__((ext_vector_type(4)));
typedef unsigned u32x4 __attribute__((ext_vector_type(4)));
constexpr int BM = 256, BK = 64, HALF = 128, HTB = HALF * BK * 2  , STAGE_BYTES = 8 * HTB, NXCD = 8, WGM = 8;

__host__ __device__ __forceinline__ int lds_byte(int r, int c) { const int st = (r >> 4) * 2 + (c >> 5), rr = r & 15, cc = c & 31, ob = rr * 64 + cc * 2; return st * 1024 + (ob ^ (((ob >> 9) & 1) << 5)); }
__host__ __device__ __forceinline__ void stage_rc(int b, int& R, int& C) { const int st = b / 1024, sb = b % 1024, swz = sb ^ (((sb >> 9) & 1) << 5); R = (st >> 1) * 16 + swz / 64; C = (st & 1) * 32 + (swz % 64) / 2; }
__host__ __device__ __forceinline__ int perm32(int rho) { const int n = rho >> 4, i = rho & 15; return 8 * (i >> 2) + 4 * n + (i & 3); }

struct Unit { int pm, pn; };
struct Gemm { const bf16_t* A; const bf16_t* Bt; int M, N, K; };

struct StaticOrder {
    int nM, nN, nwg, G, c;
    __host__ __device__ void init(int M, int N, int G_, int c_) { nM = M / BM; nN = N / BM; nwg = nM * nN; G = G_; c = c_; }
    __host__ __device__ bool next(int i, Unit& u) const {
        const long L = (long)i * G + c; if (L >= nwg) return false;
        int wgid = (int)L; { const int q = nwg / NXCD, r = nwg % NXCD, xcd = wgid % NXCD, off = wgid / NXCD; wgid = (xcd < r ? xcd * (q + 1) : r * (q + 1) + (xcd - r) * q) + off; }
        const int nig = WGM * nN, gid = wgid / nig, fm = gid * WGM, gsz = (nM - fm) < WGM ? (nM - fm) : WGM;
        u.pm = fm + ((wgid % nig) % gsz); u.pn = (wgid % nig) / gsz; return true;
    }
    __device__ __forceinline__ void a_ready(const Unit&) const {}
    __device__ __forceinline__ void done(const Unit&) const {}
};
typedef float f32x2_t_ __attribute__((ext_vector_type(2))); typedef __bf16 bf16x2_t_ __attribute__((ext_vector_type(2)));
__device__ __forceinline__ unsigned cvt_pk_bf16(float lo, float hi) { f32x2_t_ v = {lo, hi}; bf16x2_t_ b = __builtin_convertvector(v, bf16x2_t_); return __builtin_bit_cast(unsigned, b); }


template <class Epi, class Sched, bool ALIGN_EPI = false, bool SP2 = false>
__device__ __forceinline__ void gemm_phase(PG8_LAS unsigned char* lds, const Gemm g, const Sched& S, const Epi& E) {
    int tid_ = threadIdx.x; asm volatile("" : "+v"(tid_)); const int tid = tid_, wid = __builtin_amdgcn_readfirstlane(tid >> 6), lane = tid & 63, wr = wid >> 2, wc = wid & 3, fr = lane & 15, fq = lane >> 4;
    const int K = g.K, nt = K / BK;
    unsigned voffA[2], voffB[2];
#pragma unroll
    for (int i = 0; i < 2; ++i) { int R, C; stage_rc(tid * 16 + i * 8192, R, C); const int Rb = Epi::PERM ? ((R & ~31) + perm32(R & 31)) : R;
        voffA[i] = (unsigned)(R * K + C) * 2u; voffB[i] = (unsigned)(Rb * K + C) * 2u; }
    const size_t kstep = (size_t)(BK * 2);
    const size_t hstep = (size_t)HALF * K * 2;
    const size_t tstep = 2 * hstep;
    const unsigned ldsw = (unsigned)wid * 1024u;
    const int aoff = lds_byte(wr * 64 + fr, fq * 8), boff = lds_byte(wc * 32 + fr, fq * 8);
#define PG8_SA(b, h) (((b) * 2 + (h)) * HTB)
#define PG8_SB(b, h) ((4 + (b) * 2 + (h)) * HTB)
#define PG8_STAGE(bufoff, gbase, voff) do { _Pragma("unroll") for (int _i = 0; _i < 2; ++_i) { unsigned _vo = (voff)[_i]; asm volatile("" : "+v"(_vo)); \
        __builtin_amdgcn_global_load_lds((const unsigned*)((const char*)(gbase) + _vo), (PG8_LAS unsigned*)(lds + (bufoff) + ldsw + _i * 8192), 16, 0, 0); } } while (0)
#define PG8_LDA(dst, b, h) do { _Pragma("unroll") for (int m = 0; m < 4; ++m) _Pragma("unroll") for (int k = 0; k < 2; ++k) dst[m][k] = *(const PG8_LAS bf16x8*)(lds + PG8_SA(b, h) + aoff + m * 2048 + k * 1024); } while (0)
#define PG8_LDB(dst, b, h) do { _Pragma("unroll") for (int n = 0; n < 2; ++n) _Pragma("unroll") for (int k = 0; k < 2; ++k) dst[n][k] = *(const PG8_LAS bf16x8*)(lds + PG8_SB(b, h) + boff + n * 2048 + k * 1024); } while (0)
#define PG8_MMA(ai, bj, At, Bt) do { __builtin_amdgcn_s_setprio(1); _Pragma("unroll") for (int m = 0; m < 4; ++m) _Pragma("unroll") for (int n = 0; n < 2; ++n) _Pragma("unroll") for (int k = 0; k < 2; ++k) \
        acc[ai][bj][m][n] = __builtin_amdgcn_mfma_f32_16x16x32_bf16(Bt[n][k], At[m][k], acc[ai][bj][m][n], 0, 0, 0); __builtin_amdgcn_s_setprio(0); } while (0)
#define PG8_WAIT_V(n) asm volatile("s_waitcnt vmcnt(" #n ")" ::: "memory")
#define PG8_WAIT_L(n) asm volatile("s_waitcnt lgkmcnt(" #n ")" ::: "memory")
#define PG8_BAR __builtin_amdgcn_s_barrier()
#define PG8_SCHED __builtin_amdgcn_sched_barrier(0)
    Unit cur, nxt; int ui = 0;
    if (!S.next(0, cur)) return;
    f32x4 acc[2][2][4][2];
#pragma unroll
    for (int a = 0; a < 2; ++a)
#pragma unroll
        for (int b = 0; b < 2; ++b)
#pragma unroll
            for (int m = 0; m < 4; ++m)
#pragma unroll
                for (int n = 0; n < 2; ++n) acc[a][b][m][n] = (f32x4){0.f, 0.f, 0.f, 0.f};
    bf16x8 At[4][2], B0[2][2], B1[2][2];
    const char* cA = (const char*)g.A + (size_t)cur.pm * tstep; const char* cB = (const char*)g.Bt + (size_t)cur.pn * tstep;
    S.a_ready(cur);
    if constexpr (SP2) {
        PG8_STAGE(PG8_SB(0, 0), cB, voffB); PG8_STAGE(PG8_SB(0, 1), cB + hstep, voffB); PG8_STAGE(PG8_SA(0, 0), cA, voffA); PG8_STAGE(PG8_SA(0, 1), cA + hstep, voffA);
        if (wr == 1) PG8_BAR;
        PG8_WAIT_V(2); PG8_BAR;
        PG8_STAGE(PG8_SB(1, 0), cB + kstep, voffB); PG8_STAGE(PG8_SA(1, 0), cA + kstep, voffA); PG8_STAGE(PG8_SB(1, 1), cB + hstep + kstep, voffB);
        PG8_WAIT_V(6); PG8_BAR;
    } else {
        PG8_STAGE(PG8_SB(0, 0), cB, voffB); PG8_STAGE(PG8_SA(0, 0), cA, voffA); PG8_STAGE(PG8_SB(0, 1), cB + hstep, voffB); PG8_STAGE(PG8_SA(0, 1), cA + hstep, voffA);
        if (wr == 1) PG8_BAR;
        PG8_WAIT_V(4); PG8_BAR;
        PG8_STAGE(PG8_SB(1, 0), cB + kstep, voffB); PG8_STAGE(PG8_SA(1, 0), cA + kstep, voffA); PG8_STAGE(PG8_SB(1, 1), cB + hstep + kstep, voffB);
        PG8_WAIT_V(6); PG8_BAR;
    }
    for (;;) {
        const bool has_next = S.next(ui + 1, nxt);
        const char* nA = has_next ? (const char*)g.A + (size_t)nxt.pm * tstep : cA; const char* nB = has_next ? (const char*)g.Bt + (size_t)nxt.pn * tstep : cB;
        for (int t = 0; t < nt; t += 2) {
            const bool last = (t == nt - 2);
            const char* a1 = cA + (size_t)(t + 1) * kstep;
            const char* a2 = last ? nA : cA + (size_t)(t + 2) * kstep; const char* b2 = last ? nB : cB + (size_t)(t + 2) * kstep;
            const char* a3 = a2 + kstep; const char* b3 = b2 + kstep;
            if (last && has_next) S.a_ready(nxt);
            if constexpr (SP2) {
            PG8_LDB(B0, 0, 0); PG8_LDB(B1, 0, 1); PG8_SCHED; PG8_LDA(At, 0, 0); PG8_STAGE(PG8_SA(1, 1), a1 + hstep, voffA);
            PG8_WAIT_V(8); PG8_WAIT_L(0); PG8_BAR; PG8_MMA(0, 0, At, B0); PG8_MMA(0, 1, At, B1); PG8_BAR; PG8_SCHED;
            PG8_LDA(At, 0, 1); PG8_STAGE(PG8_SB(0, 0), b2, voffB); PG8_STAGE(PG8_SB(0, 1), b2 + hstep, voffB); PG8_STAGE(PG8_SA(0, 0), a2, voffA);
            PG8_WAIT_V(8); PG8_WAIT_L(0); PG8_BAR; PG8_MMA(1, 0, At, B0); PG8_MMA(1, 1, At, B1); PG8_BAR; PG8_SCHED;
            PG8_LDB(B0, 1, 0); PG8_LDB(B1, 1, 1); PG8_SCHED; PG8_LDA(At, 1, 0); PG8_STAGE(PG8_SA(0, 1), a2 + hstep, voffA);
            PG8_WAIT_V(8); PG8_WAIT_L(0); PG8_BAR; PG8_MMA(0, 0, At, B0); PG8_MMA(0, 1, At, B1); PG8_BAR; PG8_SCHED;
            PG8_LDA(At, 1, 1); PG8_STAGE(PG8_SB(1, 0), b3, voffB); PG8_STAGE(PG8_SB(1, 1), b3 + hstep, voffB); PG8_STAGE(PG8_SA(1, 0), a3, voffA);
            PG8_WAIT_V(8); PG8_WAIT_L(0); PG8_BAR; PG8_MMA(1, 0, At, B0); PG8_MMA(1, 1, At, B1); PG8_BAR; PG8_SCHED;
            } else {
            PG8_LDB(B0, 0, 0); PG8_SCHED; PG8_LDA(At, 0, 0); PG8_STAGE(PG8_SA(1, 1), a1 + hstep, voffA);
            PG8_WAIT_L(8); PG8_BAR; PG8_WAIT_L(0); PG8_MMA(0, 0, At, B0); PG8_BAR; PG8_SCHED;
            PG8_LDB(B1, 0, 1); PG8_STAGE(PG8_SB(0, 0), b2, voffB);
            PG8_BAR; PG8_WAIT_L(0); PG8_MMA(0, 1, At, B1); PG8_BAR;
            PG8_LDA(At, 0, 1); PG8_STAGE(PG8_SA(0, 0), a2, voffA);
            PG8_BAR; PG8_WAIT_L(0); PG8_MMA(1, 0, At, B0); PG8_BAR; PG8_SCHED;
            PG8_STAGE(PG8_SB(0, 1), b2 + hstep, voffB);
            PG8_WAIT_V(6); PG8_BAR; PG8_MMA(1, 1, At, B1); PG8_BAR;
            PG8_LDB(B0, 1, 0); PG8_SCHED; PG8_LDA(At, 1, 0); PG8_STAGE(PG8_SA(0, 1), a2 + hstep, voffA);
            PG8_WAIT_L(8); PG8_BAR; PG8_WAIT_L(0); PG8_MMA(0, 0, At, B0); PG8_BAR; PG8_SCHED;
            PG8_LDB(B1, 1, 1); PG8_STAGE(PG8_SB(1, 0), b3, voffB);
            PG8_BAR; PG8_WAIT_L(0); PG8_MMA(0, 1, At, B1); PG8_BAR;
            PG8_LDA(At, 1, 1); PG8_STAGE(PG8_SA(1, 0), a3, voffA);
            PG8_BAR; PG8_WAIT_L(0); PG8_MMA(1, 0, At, B0); PG8_BAR; PG8_SCHED;
            PG8_STAGE(PG8_SB(1, 1), b3 + hstep, voffB);
            PG8_WAIT_V(6); PG8_BAR; PG8_MMA(1, 1, At, B1); PG8_BAR;
            }
        }
        if constexpr (ALIGN_EPI) { if (wr == 0) PG8_BAR; }
        if constexpr (!Epi::AFTER_DRAIN) { E(acc, cur, wr, wc, fr, fq); S.done(cur); }
        if (!has_next) break;
#pragma unroll
        for (int a = 0; a < 2; ++a)
#pragma unroll
            for (int b = 0; b < 2; ++b)
#pragma unroll
                for (int m = 0; m < 4; ++m)
#pragma unroll
                    for (int n = 0; n < 2; ++n) acc[a][b][m][n] = (f32x4){0.f, 0.f, 0.f, 0.f};
        cur = nxt; cA = nA; cB = nB; ++ui;
        if constexpr (ALIGN_EPI) { if (wr == 1) PG8_BAR; }
    }
    PG8_WAIT_V(0);
    if constexpr (!ALIGN_EPI) { if (wr == 0) PG8_BAR; }
    PG8_BAR;
    if constexpr (Epi::AFTER_DRAIN) { E.fused(acc, cur, wr, wc, fr, fq, lds, wid, lane); S.done(cur); }
#undef PG8_SA
#undef PG8_SB
#undef PG8_STAGE
#undef PG8_LDA
#undef PG8_LDB
#undef PG8_MMA
#undef PG8_WAIT_V
#undef PG8_WAIT_L
#undef PG8_BAR
#undef PG8_SCHED
}
}

using pg8::bf16_t; using pg8::bf16x8; using pg8::f32x4; using pg8::u32x4; using pg8::cvt_pk_bf16;

constexpr int NTOK = 16384, SEQ = 4096, DM = 1024, DEPTH = 4;
constexpr int HB = 2304, HS = 768, FF = 2816, INC = 2976;
constexpr int NTHR = 512;
constexpr int LDS_BYTES = 147456;
constexpr int LDS_ITEM_OFF = LDS_BYTES - 64;
constexpr int P2_CONV = 128;
constexpr int P2_ITEMS = 128 + 512 + P2_CONV;

constexpr size_t MiB = 1u << 20;
constexpr size_t WS_CTR = 0, WS_SSQ = 4096, WS_SMALLW = 1 * MiB, WS_WIN = 4 * MiB, WS_WO = 10 * MiB, WS_WGU = 12 * MiB, WS_WDN = 23 * MiB,
                 WS_HBIG = 29 * MiB, WS_ACT = 29 * MiB, WS_MLA = 101 * MiB, WS_MIXED = 133 * MiB, WS_HSMALL = 165 * MiB, WS_STREAMS = 189 * MiB,
                 WS_XB = 189 * MiB, WS_SSQ64 = 253 * MiB, WS_BAR = 254 * MiB + 512 * 1024, WS_END = 255 * MiB;
constexpr size_t SMALLW_LAYER = 589824;
constexpr size_t SW_WUP = 0, SW_AUP = 65536, SW_GUP = 131072, SW_UQ = 262144, SW_UKV = 458752;
constexpr size_t STREAM_BYTES = (size_t)NTOK * 512 * 2;
constexpr size_t MLA_Q = 0, MLA_K = 12 * MiB, MLA_V = 24 * MiB;

struct Params {
    const float* x; const int* pos; const float* attn_norm_g; const float* w_in; const float* mu; const float* w_up; const float* w0;
    const float* a_up; const float* a0; const float* g_up; const float* k_k; const float* k_a; const float* r_k; const float* ln_g;
    const float* ln_b; const float* cq_g; const float* ckv_g; const float* w_uq; const float* w_ukv; const float* qn_g; const float* kn_g;
    const float* w_o; const float* ffn_g; const float* w_gate; const float* w_upf; const float* w_down;
    float* out; unsigned char* ws;
    int ph_lo, ph_hi;
};

__device__ __forceinline__ float bflo(unsigned u) { return __uint_as_float(u << 16); }
__device__ __forceinline__ float bfhi(unsigned u) { return __uint_as_float(u & 0xffff0000u); }
__device__ __forceinline__ float bf1(bf16_t b) { return __uint_as_float((unsigned)b << 16); }
__device__ __forceinline__ bf16_t f2bf(float f) { return (bf16_t)(cvt_pk_bf16(f, 0.f) & 0xffffu); }
__device__ __forceinline__ float wave_sum(float v) {
#pragma unroll
    for (int o = 1; o < 64; o <<= 1) v += __shfl_xor(v, o);
    return v;
}
#define LDS_WAIT() asm volatile("s_waitcnt lgkmcnt(0)" ::: "memory")
#define LDS_BARRIER() asm volatile("s_waitcnt lgkmcnt(0)\n\ts_barrier" ::: "memory")
__device__ __forceinline__ float sigmoidf_(float x) { return __builtin_amdgcn_rcpf(1.f + __expf(-x)); }
__device__ __forceinline__ float softplusf_(float x) { return fmaxf(x, 0.f) + __logf(1.f + __expf(-fabsf(x))); }
__device__ __forceinline__ float shiftf(float cur, float prev, float mu) { return cur + mu * (prev - cur); }
#define DPP_ROR_ADD(x, n) ((x) + __builtin_bit_cast(float, __builtin_amdgcn_update_dpp(0, __builtin_bit_cast(int, (x)), 0x120 + (n), 0xf, 0xf, false)))
__device__ __forceinline__ float row16_sum(float x) {
    x = DPP_ROR_ADD(x, 8); x = DPP_ROR_ADD(x, 4); x = DPP_ROR_ADD(x, 2); x = DPP_ROR_ADD(x, 1); return x;
}

__device__ __forceinline__ void tr_item(const float* W, int K, int N, int sc, const float* g, bf16_t* WT, int drow0, LAS float* scr, int k0, int lane) {
#pragma unroll
    for (int i = 0; i < 32; ++i) {
        const int kk = 2 * i + (lane >> 5); float v = 0.f;
        if (sc >= 0) { v = W[(size_t)(k0 + kk) * N + sc]; if (g) v *= g[k0 + kk]; }
        scr[kk * 33 + (lane & 31)] = v;
    }
    LDS_WAIT();
    const int c = lane & 7;
#pragma unroll
    for (int j = 0; j < 4; ++j) {
        const int n = (lane >> 3) + 8 * j; const LAS float* s = scr + (8 * c) * 33 + n;
        u32x4 o; o.x = cvt_pk_bf16(s[0 * 33], s[1 * 33]); o.y = cvt_pk_bf16(s[2 * 33], s[3 * 33]); o.z = cvt_pk_bf16(s[4 * 33], s[5 * 33]); o.w = cvt_pk_bf16(s[6 * 33], s[7 * 33]);
        *(u32x4*)(WT + (size_t)(drow0 + n) * K + k0 + 8 * c) = o;
    }
    LDS_WAIT();
}
__device__ __forceinline__ void conv_run(const float* src0, const float* src1, const float* g, bf16_t* dst, int K, int Ns, int Nd, int mode,
                                         LAS float* scr, int gw, int ngw, int lane) {
    asm volatile("" : "+v"(lane));
    const int nnb = Nd / 32, nitems = (K / 64) * nnb;
    for (int it = gw; it < nitems; it += ngw) {
        const int kb = it / nnb, nb = it - kb * nnb, n = nb * 32 + (lane & 31);
        const float* src = src0; int sc;
        if (mode == 0) sc = n;
        else if (mode == 1) sc = n < 1536 ? n : (n < 2304 ? n + 672 : (n < 2976 ? n - 768 : -1));
        else { const int blk = n >> 8, jj = n & 255; if (jj < 128) sc = blk * 128 + jj; else { src = src1; sc = blk * 128 + jj - 128; } }
        tr_item(src, K, Ns, sc, g, dst, nb * 32, scr, kb * 64, lane);
    }
}

struct EpiH {
    static constexpr bool PERM = true, AFTER_DRAIN = false;
    bf16_t* hbig; bf16_t* hsmall; const unsigned long long* ssq;
    __device__ __forceinline__ void operator()(const f32x4 (&acc)[2][2][4][2], const pg8::Unit& u, int wr, int wc, int fr, int fq) const {
        int row0 = u.pm * 256 + wr * 64 + fr; asm volatile("" : "+v"(row0));
        bf16_t* dst; int ld, c0;
        if (u.pn < 9) { dst = hbig; ld = HB; c0 = u.pn * 256; } else { dst = hsmall; ld = HS; c0 = u.pn * 256 - HB; }
        const int col0 = c0 + wc * 32 + 8 * fq;
#pragma unroll
        for (int ai = 0; ai < 2; ++ai)
#pragma unroll
            for (int m = 0; m < 4; ++m) {
                const int row = row0 + ai * 128 + m * 16;
                const float rinv = rsqrtf((float)ssq[row] * (1.f / (1024.f * 16777216.f)) + 1e-6f);
#pragma unroll
                for (int bj = 0; bj < 2; ++bj) {
                    const f32x4 v0 = acc[ai][bj][m][0] * rinv, v1 = acc[ai][bj][m][1] * rinv;
                    u32x4 w; w.x = cvt_pk_bf16(v0[0], v0[1]); w.y = cvt_pk_bf16(v0[2], v0[3]); w.z = cvt_pk_bf16(v1[0], v1[1]); w.w = cvt_pk_bf16(v1[2], v1[3]);
                    *(u32x4*)(dst + (size_t)row * ld + col0 + bj * 128) = w;
                }
            }
    }
};
struct EpiRes {
    static constexpr bool PERM = true, AFTER_DRAIN = false;
    const float* xin; float* xout; bf16_t* xb; unsigned long long* ssq_out;
    __device__ __forceinline__ void operator()(const f32x4 (&acc)[2][2][4][2], const pg8::Unit& u, int wr, int wc, int fr, int fq) const {
        int row0 = u.pm * 256 + wr * 64 + fr, col0 = u.pn * 256 + wc * 32 + 8 * fq; asm volatile("" : "+v"(row0), "+v"(col0));
#pragma unroll
        for (int ai = 0; ai < 2; ++ai)
#pragma unroll
            for (int m = 0; m < 4; ++m) {
                const int row = row0 + ai * 128 + m * 16; float s = 0.f;
#pragma unroll
                for (int bj = 0; bj < 2; ++bj) {
                    const size_t off = (size_t)row * DM + col0 + bj * 128;
                    const f32x4 x0 = *(const f32x4*)(xin + off), x1 = *(const f32x4*)(xin + off + 4);
                    const f32x4 v0 = x0 + acc[ai][bj][m][0], v1 = x1 + acc[ai][bj][m][1];
                    *(f32x4*)(xout + off) = v0; *(f32x4*)(xout + off + 4) = v1;
                    u32x4 w; w.x = cvt_pk_bf16(v0[0], v0[1]); w.y = cvt_pk_bf16(v0[2], v0[3]); w.z = cvt_pk_bf16(v1[0], v1[1]); w.w = cvt_pk_bf16(v1[2], v1[3]);
                    *(u32x4*)(xb + off) = w;
                    s += v0[0] * v0[0] + v0[1] * v0[1] + v0[2] * v0[2] + v0[3] * v0[3] + v1[0] * v1[0] + v1[1] * v1[1] + v1[2] * v1[2] + v1[3] * v1[3];
                }
                s += __shfl_xor(s, 16); s += __shfl_xor(s, 32);
                if (fq == 0) atomicAdd(ssq_out + row, (unsigned long long)(s * 16777216.f));
            }
    }
};
struct EpiGLU {
    static constexpr bool PERM = true, AFTER_DRAIN = false;
    bf16_t* act; const unsigned long long* ssq;
    __device__ __forceinline__ void operator()(const f32x4 (&acc)[2][2][4][2], const pg8::Unit& u, int wr, int wc, int fr, int fq) const {
        int row0 = u.pm * 256 + wr * 64 + fr, col0 = u.pn * 128 + wc * 32 + 8 * fq; asm volatile("" : "+v"(row0), "+v"(col0));
#pragma unroll
        for (int ai = 0; ai < 2; ++ai)
#pragma unroll
            for (int m = 0; m < 4; ++m) {
                const int row = row0 + ai * 128 + m * 16;
                const float rinv = rsqrtf((float)ssq[row] * (1.f / (1024.f * 16777216.f)) + 1e-6f);
                float o[8];
#pragma unroll
                for (int n = 0; n < 2; ++n)
#pragma unroll
                    for (int j = 0; j < 4; ++j) { const float g = acc[ai][0][m][n][j] * rinv, up = acc[ai][1][m][n][j] * rinv; o[n * 4 + j] = g * __builtin_amdgcn_rcpf(1.f + __expf(-g)) * up; }
                u32x4 w; w.x = cvt_pk_bf16(o[0], o[1]); w.y = cvt_pk_bf16(o[2], o[3]); w.z = cvt_pk_bf16(o[4], o[5]); w.w = cvt_pk_bf16(o[6], o[7]);
                *(u32x4*)(act + (size_t)row * FF + col0) = w;
            }
    }
};

__device__ __forceinline__ void phase_prologue(const Params& p, LAS unsigned char* lds) {
    int tid_ = threadIdx.x; asm volatile("" : "+v"(tid_)); const int tid = tid_, lane = tid & 63, wave = tid >> 6;
    const int gw = blockIdx.x * 8 + wave, ngw = gridDim.x * 8;
    LAS float* scr = (LAS float*)(lds + wave * 8448);
    unsigned char* ws = p.ws;
    conv_run(p.w_in, nullptr, p.attn_norm_g, (bf16_t*)(ws + WS_WIN), 1024, INC, 3072, 1, scr, gw, ngw, lane);
    for (int l = 0; l < DEPTH; ++l) {
        unsigned char* sw = ws + WS_SMALLW + l * SMALLW_LAYER;
        const int g0 = (gw + ngw - (l * 5 + 0) * 96) % ngw, g1 = (gw + ngw - (l * 5 + 1) * 96) % ngw, g2 = (gw + ngw - (l * 5 + 2) * 96) % ngw,
                  g3 = (gw + ngw - (l * 5 + 3) * 96) % ngw, g4 = (gw + ngw - (l * 5 + 4) * 96) % ngw;
        conv_run(p.w_up + (size_t)l * 64 * 512, nullptr, nullptr, (bf16_t*)(sw + SW_WUP), 64, 512, 512, 0, scr, g0, ngw, lane);
        conv_run(p.a_up + (size_t)l * 64 * 512, nullptr, nullptr, (bf16_t*)(sw + SW_AUP), 64, 512, 512, 0, scr, g1, ngw, lane);
        conv_run(p.g_up + (size_t)l * 128 * 512, nullptr, nullptr, (bf16_t*)(sw + SW_GUP), 128, 512, 512, 0, scr, g2, ngw, lane);
        conv_run(p.w_uq + (size_t)l * 256 * 384, nullptr, p.cq_g + l * 256, (bf16_t*)(sw + SW_UQ), 256, 384, 384, 0, scr, g3, ngw, lane);
        conv_run(p.w_ukv + (size_t)l * 128 * 512, nullptr, p.ckv_g + l * 128, (bf16_t*)(sw + SW_UKV), 128, 512, 512, 0, scr, g4, ngw, lane);
    }
    unsigned long long* ssq = (unsigned long long*)(ws + WS_SSQ64);
    bf16_t* xb = (bf16_t*)(ws + WS_XB);
#pragma unroll 2
    for (int m = gw; m < NTOK; m += ngw) {
        const f32x4* xr = (const f32x4*)(p.x + (size_t)m * DM) + lane;
        f32x4 v[4]; float s = 0.f;
#pragma unroll
        for (int j = 0; j < 4; ++j) { v[j] = xr[64 * j]; s += v[j][0] * v[j][0] + v[j][1] * v[j][1] + v[j][2] * v[j][2] + v[j][3] * v[j][3]; }
        s = wave_sum(s);
        if (lane == 0) ssq[m] = (unsigned long long)(s * 16777216.f);
#pragma unroll
        for (int j = 0; j < 4; ++j) { u32x2 w; w.x = cvt_pk_bf16(v[j][0], v[j][1]); w.y = cvt_pk_bf16(v[j][2], v[j][3]); *(u32x2*)(xb + (size_t)m * DM + 256 * j + 4 * lane) = w; }
    }
    for (int i = blockIdx.x * NTHR + tid; i < 8 * NTOK; i += gridDim.x * NTHR) ssq[NTOK + i] = 0ull;
    if (blockIdx.x == 0 && tid < 16) ((unsigned*)(ws + WS_CTR))[tid] = 0u;
}

constexpr int PA_W = 0, PA_A = 9216, PA_G = 18432, PA_Q = 35840, PA_KV = 69632, PA_RQ = 87040, PA_RKV = 87296, PA_COS = 87552, PA_SIN = 91648, PA_QG = 95744, PA_KG = 96128;

template <int K, int JOB>
__device__ __forceinline__ void lora_job(const LAS bf16_t* A, const bf16_t* Bt, bf16_t* dst, const float* biasp, int tok0, int wave, int fr, int fq) {
    constexpr int NKS = K / 32, lda = K + 8;
    asm volatile("" : "+v"(fr), "+v"(fq));
#pragma unroll 1
    for (int q = 0; q < 4; ++q) {
        const int col = (wave * 4 + q) * 16 + fr;
        bf16x8 bfrq[NKS];
#pragma unroll
        for (int ks = 0; ks < NKS; ++ks) bfrq[ks] = *(const bf16x8*)(Bt + (size_t)col * K + ks * 32 + fq * 8);
        __builtin_amdgcn_sched_barrier(0);
        f32x4 acc[4];
#pragma unroll
        for (int m = 0; m < 4; ++m) acc[m] = (f32x4){0.f, 0.f, 0.f, 0.f};
#pragma unroll
        for (int ks = 0; ks < NKS; ++ks)
#pragma unroll
            for (int m = 0; m < 4; ++m) {
                const bf16x8 afr = *(const LAS bf16x8*)(A + (m * 16 + fr) * lda + ks * 32 + fq * 8);
                acc[m] = __builtin_amdgcn_mfma_f32_16x16x32_bf16(afr, bfrq[ks], acc[m], 0, 0, 0);
            }
        const float bias = (JOB == 2) ? 0.f : biasp[col];
#pragma unroll
        for (int m = 0; m < 4; ++m)
#pragma unroll
            for (int r = 0; r < 4; ++r) {
                float v = acc[m][r] + bias;
                if (JOB == 0) { const float wr_ = -softplusf_(-v) - 0.5f; v = -__expf(wr_); }
                else if (JOB == 1) v = sigmoidf_(v);
                dst[(size_t)(tok0 + m * 16 + fq * 4 + r) * 512 + col] = f2bf(v);
            }
    }
}
__device__ __forceinline__ void phase_prep(const Params& p, int l, LAS unsigned char* lds) {
    int tid_ = threadIdx.x; asm volatile("" : "+v"(tid_)); const int tid = tid_, lane = tid & 63, wave = tid >> 6;
    const int gw = blockIdx.x * 8 + wave, ngw = gridDim.x * 8;
    unsigned char* ws = p.ws;
    const bf16_t* hbig = (const bf16_t*)(ws + WS_HBIG);
    const bf16_t* hsm = (const bf16_t*)(ws + WS_HSMALL);
    bf16_t* s_lw = (bf16_t*)(ws + WS_STREAMS);
    bf16_t* s_a = (bf16_t*)(ws + WS_STREAMS + STREAM_BYTES);
    bf16_t* s_kk = (bf16_t*)(ws + WS_STREAMS + 2 * STREAM_BYTES);
    bf16_t* s_g = (bf16_t*)(ws + WS_STREAMS + 3 * STREAM_BYTES);
    bf16_t* mq = (bf16_t*)(ws + WS_MLA + MLA_Q);
    bf16_t* mk = (bf16_t*)(ws + WS_MLA + MLA_K);
    bf16_t* mv = (bf16_t*)(ws + WS_MLA + MLA_V);
    const unsigned char* sw = ws + WS_SMALLW + l * SMALLW_LAYER;
    const bf16_t* wup_t = (const bf16_t*)(sw + SW_WUP); const bf16_t* aup_t = (const bf16_t*)(sw + SW_AUP); const bf16_t* gup_t = (const bf16_t*)(sw + SW_GUP);
    const bf16_t* uq_t = (const bf16_t*)(sw + SW_UQ); const bf16_t* ukv_t = (const bf16_t*)(sw + SW_UKV);
    const float* mu = p.mu + l * 1792;
    LAS bf16_t* A_w = (LAS bf16_t*)(lds + PA_W); LAS bf16_t* A_a = (LAS bf16_t*)(lds + PA_A); LAS bf16_t* A_g = (LAS bf16_t*)(lds + PA_G);
    LAS bf16_t* A_q = (LAS bf16_t*)(lds + PA_Q); LAS bf16_t* A_kv = (LAS bf16_t*)(lds + PA_KV);
    LAS float* rinvq = (LAS float*)(lds + PA_RQ); LAS float* rinvkv = (LAS float*)(lds + PA_RKV);
    LAS float* cosT = (LAS float*)(lds + PA_COS); LAS float* sinT = (LAS float*)(lds + PA_SIN);
    LAS float* qgL = (LAS float*)(lds + PA_QG); LAS float* kgL = (LAS float*)(lds + PA_KG);
    const int fr = lane & 15, fq = lane >> 4;

    for (int tile = blockIdx.x; tile < NTOK / 64; tile += gridDim.x) {
        const int tok0 = tile * 64, t0 = tok0 & (SEQ - 1), bidx = tok0 / SEQ;
#pragma unroll
        for (int i = 0; i < 4; ++i) {
            const int id = tid + i * NTHR, tk = id >> 5, c8 = (id & 31) * 8;
            const u32x4 cur = *(const u32x4*)(hsm + (size_t)(tok0 + tk) * HS + c8);
            u32x4 prv = {0u, 0u, 0u, 0u};
            if (t0 + tk > 0) prv = *(const u32x4*)(hsm + (size_t)(tok0 + tk - 1) * HS + c8);
            float o[8];
#pragma unroll
            for (int j = 0; j < 4; ++j) {
                o[2 * j] = shiftf(bflo(cur[j]), bflo(prv[j]), mu[1536 + c8 + 2 * j]);
                o[2 * j + 1] = shiftf(bfhi(cur[j]), bfhi(prv[j]), mu[1536 + c8 + 2 * j + 1]);
            }
            LAS bf16_t* dstp;
            if (c8 < 64) {
#pragma unroll
                for (int j = 0; j < 8; ++j) { const float e = __expf(2.f * o[j]); o[j] = 1.f - 2.f * __builtin_amdgcn_rcpf(e + 1.f); }
                dstp = A_w + tk * 72 + c8;
            } else if (c8 < 128) { dstp = A_a + tk * 72 + (c8 - 64); }
            else {
#pragma unroll
                for (int j = 0; j < 8; ++j) o[j] = sigmoidf_(o[j]);
                dstp = A_g + tk * 136 + (c8 - 128);
            }
            u32x4 w; w.x = cvt_pk_bf16(o[0], o[1]); w.y = cvt_pk_bf16(o[2], o[3]); w.z = cvt_pk_bf16(o[4], o[5]); w.w = cvt_pk_bf16(o[6], o[7]);
            *(LAS u32x4*)dstp = w;
        }
#pragma unroll
        for (int i = 0; i < 4; ++i) {
            const int tk = wave * 8 + i * 2 + (lane >> 5), c8 = (lane & 31) * 8;
            const u32x4 cur = *(const u32x4*)(hsm + (size_t)(tok0 + tk) * HS + 256 + c8);
            float s = 0.f;
#pragma unroll
            for (int j = 0; j < 4; ++j) { const float a = bflo(cur[j]), b = bfhi(cur[j]); s += a * a + b * b; }
#pragma unroll
            for (int o = 1; o < 32; o <<= 1) s += __shfl_xor(s, o);
            *(LAS u32x4*)(A_q + tk * 264 + c8) = cur;
            if ((lane & 31) == 0) rinvq[tk] = rsqrtf(s * (1.f / 256.f) + 1e-6f);
        }
#pragma unroll
        for (int i = 0; i < 2; ++i) {
            const int tk = wave * 8 + i * 4 + (lane >> 4), c8 = (lane & 15) * 8;
            const u32x4 cur = *(const u32x4*)(hsm + (size_t)(tok0 + tk) * HS + 512 + c8);
            float s = 0.f;
#pragma unroll
            for (int j = 0; j < 4; ++j) { const float a = bflo(cur[j]), b = bfhi(cur[j]); s += a * a + b * b; }
#pragma unroll
            for (int o = 1; o < 16; o <<= 1) s += __shfl_xor(s, o);
            *(LAS u32x4*)(A_kv + tk * 136 + c8) = cur;
            if ((lane & 15) == 0) rinvkv[tk] = rsqrtf(s * (1.f / 128.f) + 1e-6f);
        }
        if (tid < 96) { qgL[tid] = p.qn_g[l * 96 + tid]; kgL[tid] = p.kn_g[l * 96 + tid]; }
#pragma unroll
        for (int i = 0; i < 2; ++i) {
            const int id = tid + i * NTHR, tk = id >> 4, fi = id & 15;
            double invf = 1.0; for (int k_ = 0; k_ < fi; ++k_) invf *= 0.56234132519034908;
            const double ang = (double)p.pos[tok0 + tk] * invf;
            const double rev = ang * 0.15915494309189533577;
            const float fr_ = (float)(rev - __builtin_rint(rev));
            cosT[id] = __builtin_amdgcn_cosf(fr_); sinT[id] = __builtin_amdgcn_sinf(fr_);
        }
#pragma unroll 2
        for (int i = 0; i < 8; ++i) {
            const int tk = wave * 8 + i, c0 = lane * 8;
            const u32x4 cur = *(const u32x4*)(hbig + (size_t)(tok0 + tk) * HB + 512 + c0);
            u32x4 prv = {0u, 0u, 0u, 0u};
            if (t0 + tk > 0) prv = *(const u32x4*)(hbig + (size_t)(tok0 + tk - 1) * HB + 512 + c0);
            float o[8]; float s = 0.f;
#pragma unroll
            for (int j = 0; j < 4; ++j) {
                o[2 * j] = shiftf(bflo(cur[j]), bflo(prv[j]), mu[512 + c0 + 2 * j]) * p.k_k[l * 512 + c0 + 2 * j];
                o[2 * j + 1] = shiftf(bfhi(cur[j]), bfhi(prv[j]), mu[512 + c0 + 2 * j + 1]) * p.k_k[l * 512 + c0 + 2 * j + 1];
                s += o[2 * j] * o[2 * j] + o[2 * j + 1] * o[2 * j + 1];
            }
            s += __shfl_xor(s, 1); s += __shfl_xor(s, 2); s += __shfl_xor(s, 4);
            const float rn = rsqrtf(s + 1e-12f);
            u32x4 w; w.x = cvt_pk_bf16(o[0] * rn, o[1] * rn); w.y = cvt_pk_bf16(o[2] * rn, o[3] * rn); w.z = cvt_pk_bf16(o[4] * rn, o[5] * rn); w.w = cvt_pk_bf16(o[6] * rn, o[7] * rn);
            *(u32x4*)(s_kk + (size_t)(tok0 + tk) * 512 + c0) = w;
        }
        __syncthreads();
        lora_job<64, 0>(A_w, wup_t, s_lw, p.w0 + l * 512, tok0, wave, fr, fq);
        lora_job<64, 1>(A_a, aup_t, s_a, p.a0 + l * 512, tok0, wave, fr, fq);
        lora_job<128, 2>(A_g, gup_t, s_g, nullptr, tok0, wave, fr, fq);
#pragma unroll 1
        for (int cc = 0; cc < 2; ++cc) {
            const int combo = wave * 2 + cc, hd = combo >> 2, mt = combo & 3;
            f32x4 acc[6];
#pragma unroll
            for (int n = 0; n < 6; ++n) acc[n] = (f32x4){0.f, 0.f, 0.f, 0.f};
#pragma unroll 1
            for (int kh = 0; kh < 4; ++kh) {
                bf16x8 bfr[2][6];
#pragma unroll
                for (int k4 = 0; k4 < 2; ++k4)
#pragma unroll
                    for (int n = 0; n < 6; ++n) bfr[k4][n] = *(const bf16x8*)(uq_t + (size_t)(hd * 96 + n * 16 + fr) * 256 + (kh * 2 + k4) * 32 + fq * 8);
                __builtin_amdgcn_sched_barrier(0);
#pragma unroll
                for (int k4 = 0; k4 < 2; ++k4) {
                    const bf16x8 afr = *(const LAS bf16x8*)(A_q + (mt * 16 + fr) * 264 + (kh * 2 + k4) * 32 + fq * 8);
#pragma unroll
                    for (int n = 0; n < 6; ++n) acc[n] = __builtin_amdgcn_mfma_f32_16x16x32_bf16(afr, bfr[k4][n], acc[n], 0, 0, 0);
                }
            }
            const float qscale = 0.10206207261596575f * 1.4426950408889634f;
#pragma unroll
            for (int r = 0; r < 4; ++r) {
                const int tk = mt * 16 + fq * 4 + r; const float rq = rinvq[tk];
                float v[6]; float ss = 0.f;
#pragma unroll
                for (int n = 0; n < 6; ++n) { v[n] = acc[n][r] * rq; ss += v[n] * v[n]; }
                ss = row16_sum(ss);
                const float rh = 1.0f / sqrtf(ss * (1.f / 96.f) + 1e-6f);
#pragma unroll
                for (int n = 0; n < 6; ++n) v[n] = v[n] * rh * qgL[n * 16 + fr];
                const float c = cosT[tk * 16 + fr], s = sinT[tk * 16 + fr];
                const float x1 = v[4], x2 = v[5]; v[4] = x1 * c - x2 * s; v[5] = x1 * s + x2 * c;
                bf16_t* qo = mq + ((size_t)(bidx * 4 + hd) * SEQ + t0 + tk) * 96 + fr;
#pragma unroll
                for (int n = 0; n < 6; ++n) qo[n * 16] = f2bf(v[n] * qscale);
            }
        }
#pragma unroll 1
        for (int cc = 0; cc < 2; ++cc) {
            const int combo = wave * 2 + cc, hd = combo >> 2, mt = combo & 3;
            f32x4 acc[8];
#pragma unroll
            for (int n = 0; n < 8; ++n) acc[n] = (f32x4){0.f, 0.f, 0.f, 0.f};
#pragma unroll 1
            for (int kh = 0; kh < 2; ++kh) {
                bf16x8 bfr[2][8];
#pragma unroll
                for (int k2 = 0; k2 < 2; ++k2)
#pragma unroll
                    for (int n = 0; n < 8; ++n) bfr[k2][n] = *(const bf16x8*)(ukv_t + (size_t)(hd * 128 + n * 16 + fr) * 128 + (kh * 2 + k2) * 32 + fq * 8);
                __builtin_amdgcn_sched_barrier(0);
#pragma unroll
                for (int k2 = 0; k2 < 2; ++k2) {
                    const bf16x8 afr = *(const LAS bf16x8*)(A_kv + (mt * 16 + fr) * 136 + (kh * 2 + k2) * 32 + fq * 8);
#pragma unroll
                    for (int n = 0; n < 8; ++n) acc[n] = __builtin_amdgcn_mfma_f32_16x16x32_bf16(afr, bfr[k2][n], acc[n], 0, 0, 0);
                }
            }
#pragma unroll
            for (int r = 0; r < 4; ++r) {
                const int tk = mt * 16 + fq * 4 + r; const float rk = rinvkv[tk];
                const float kr1 = bf1(hsm[(size_t)(tok0 + tk) * HS + 640 + fr]), kr2 = bf1(hsm[(size_t)(tok0 + tk) * HS + 656 + fr]);
                float v[4]; float ss = kr1 * kr1 + kr2 * kr2;
#pragma unroll
                for (int n = 0; n < 4; ++n) { v[n] = acc[n][r] * rk; ss += v[n] * v[n]; }
                ss = row16_sum(ss);
                const float rh = 1.0f / sqrtf(ss * (1.f / 96.f) + 1e-6f);
                const float c = cosT[tk * 16 + fr], s = sinT[tk * 16 + fr];
                const float x1 = kr1 * rh * kgL[64 + fr], x2 = kr2 * rh * kgL[80 + fr];
                bf16_t* ko = mk + ((size_t)(bidx * 4 + hd) * SEQ + t0 + tk) * 96 + fr;
#pragma unroll
                for (int n = 0; n < 4; ++n) ko[n * 16] = f2bf(v[n] * rh * kgL[n * 16 + fr]);
                ko[64] = f2bf(x1 * c - x2 * s); ko[80] = f2bf(x1 * s + x2 * c);
                bf16_t* vo = mv + ((size_t)(bidx * 4 + hd) * SEQ + t0 + tk) * 64 + fr;
#pragma unroll
                for (int n = 0; n < 4; ++n) vo[n * 16] = f2bf(acc[4 + n][r] * rk);
            }
        }
        __syncthreads();
    }
}

constexpr int SC_STEPF = 336;
constexpr int SC_CH = 32;
constexpr int SC_BUF_BYTES = SC_CH * SC_STEPF * 4;
constexpr int SC_YOFF = 2 * SC_BUF_BYTES;

struct ScanRegs { unsigned rc[4], rp[4], kc[4], kp[4], av[4], kkv[4], lwv[4]; unsigned vc, vp; };
struct ScanConst { float mur0, mur1, muk0, muk1, ka0, ka1, muv0, muv1; };
__device__ __forceinline__ void scan_load(const Params& p, ScanRegs& R, int b, int h, int rq, int chunk, int lt) {
    const unsigned char* ws = p.ws;
    const bf16_t* hbig = (const bf16_t*)(ws + WS_HBIG);
    const bf16_t* s_lw = (const bf16_t*)(ws + WS_STREAMS);
    const bf16_t* s_a = (const bf16_t*)(ws + WS_STREAMS + STREAM_BYTES);
    const bf16_t* s_kk = (const bf16_t*)(ws + WS_STREAMS + 2 * STREAM_BYTES);
    const int jp = lt & 31, c = h * 64 + 2 * jp;
#pragma unroll
    for (int i = 0; i < 4; ++i) {
        const int s = (lt >> 5) + 8 * i, t = chunk * SC_CH + s; const size_t tok = (size_t)b * SEQ + t;
        R.rc[i] = *(const unsigned*)(hbig + tok * HB + c); R.kc[i] = *(const unsigned*)(hbig + tok * HB + 512 + c);
        R.rp[i] = 0u; R.kp[i] = 0u;
        if (t > 0) { R.rp[i] = *(const unsigned*)(hbig + (tok - 1) * HB + c); R.kp[i] = *(const unsigned*)(hbig + (tok - 1) * HB + 512 + c); }
        R.av[i] = *(const unsigned*)(s_a + tok * 512 + c); R.kkv[i] = *(const unsigned*)(s_kk + tok * 512 + c); R.lwv[i] = *(const unsigned*)(s_lw + tok * 512 + c);
    }
    {
        const int s = lt >> 3, ip = lt & 7, t = chunk * SC_CH + s, cv = h * 64 + rq * 16 + 2 * ip; const size_t tok = (size_t)b * SEQ + t;
        R.vc = *(const unsigned*)(hbig + tok * HB + 1024 + cv);
        R.vp = 0u; if (t > 0) R.vp = *(const unsigned*)(hbig + (tok - 1) * HB + 1024 + cv);
    }
}
__device__ __forceinline__ void scan_write(const ScanRegs& R, const ScanConst& C, LAS float* buf, int lt) {
    const int jp = lt & 31;
#pragma unroll
    for (int i = 0; i < 4; ++i) {
        const int s = (lt >> 5) + 8 * i;
        const float a0 = bflo(R.av[i]), a1 = bfhi(R.av[i]), kk0 = bflo(R.kkv[i]), kk1 = bfhi(R.kkv[i]);
        LAS float* o = buf + s * SC_STEPF + 2 * jp;
        *(LAS f32x2*)(o) = (f32x2){-kk0, -kk1};
        *(LAS f32x2*)(o + 64) = (f32x2){__expf(bflo(R.lwv[i])), __expf(bfhi(R.lwv[i]))};
        *(LAS f32x2*)(o + 128) = (f32x2){kk0 * a0, kk1 * a1};
        const float ks0 = shiftf(bflo(R.kc[i]), bflo(R.kp[i]), C.muk0), ks1 = shiftf(bfhi(R.kc[i]), bfhi(R.kp[i]), C.muk1);
        *(LAS f32x2*)(o + 192) = (f32x2){ks0 * (1.f + (a0 - 1.f) * C.ka0), ks1 * (1.f + (a1 - 1.f) * C.ka1)};
        *(LAS f32x2*)(o + 256) = (f32x2){shiftf(bflo(R.rc[i]), bflo(R.rp[i]), C.mur0), shiftf(bfhi(R.rc[i]), bfhi(R.rp[i]), C.mur1)};
    }
    {
        const int s = lt >> 3, ip = lt & 7;
        *(LAS f32x2*)(buf + s * SC_STEPF + 320 + 2 * ip) = (f32x2){shiftf(bflo(R.vc), bflo(R.vp), C.muv0), shiftf(bfhi(R.vc), bfhi(R.vp), C.muv1)};
    }
}
__device__ __forceinline__ void scan_flush(const Params& p, const LAS float* yb, int b, int h, int rq, int chunk, int lt) {
    bf16_t* mixed = (bf16_t*)(p.ws + WS_MIXED);
#pragma unroll
    for (int j = 0; j < 2; ++j) {
        const int id = lt + 256 * j, s = id >> 4, row = id & 15, t = chunk * SC_CH + s; const size_t tok = (size_t)b * SEQ + t;
        const f32x4 q = *(const LAS f32x4*)(yb + id * 8), q2 = *(const LAS f32x4*)(yb + id * 8 + 4);
        mixed[tok * 1024 + h * 64 + rq * 16 + row] = f2bf(((q[0] + q[1]) + (q[2] + q[3])) + ((q2[0] + q2[1]) + (q2[2] + q2[3])));
    }
}
struct StepOps { f32x4 na, w, bb, kk, r; float v; };
#define SC_LD(X, s_) do { const LAS float* vb_ = cur + (s_) * SC_STEPF; X.na = *(const LAS f32x4*)(vb_ + c4); X.w = *(const LAS f32x4*)(vb_ + 64 + c4); \
        X.bb = *(const LAS f32x4*)(vb_ + 128 + c4); X.kk = *(const LAS f32x4*)(vb_ + 192 + c4); X.r = *(const LAS f32x4*)(vb_ + 256 + c4); X.v = vb_[320 + row]; } while (0)
#define SC_STEP(X, s_) do { \
        float sa = (S0 * X.na[0] + S2 * X.na[2]) + (S1 * X.na[1] + S3 * X.na[3]); \
        const float u0 = S0 * X.w[0] + X.v * X.kk[0], u1 = S1 * X.w[1] + X.v * X.kk[1], u2 = S2 * X.w[2] + X.v * X.kk[2], u3 = S3 * X.w[3] + X.v * X.kk[3]; \
        sa = row16_sum(sa); \
        S0 = u0 + sa * X.bb[0]; S1 = u1 + sa * X.bb[1]; S2 = u2 + sa * X.bb[2]; S3 = u3 + sa * X.bb[3]; \
        float y = (S0 * X.r[0] + S2 * X.r[2]) + (S1 * X.r[1] + S3 * X.r[3]); \
        y = DPP_ROR_ADD(y, 8); yp[(s_) * 128] = y; } while (0)
__device__ __forceinline__ void scan_unit(const Params& p, int l, LAS unsigned char* lds, int unit) {
    int tid_ = threadIdx.x; asm volatile("" : "+v"(tid_)); const int tid = tid_, lane = tid & 63, wave = tid >> 6;
    const int rq = unit & 3, h = (unit >> 2) & 7, b = unit >> 5;
    LAS float* buf0 = (LAS float*)lds; LAS float* buf1 = (LAS float*)(lds + SC_BUF_BYTES);
    LAS float* yb0 = (LAS float*)(lds + SC_YOFF); LAS float* yb1 = yb0 + SC_CH * 128;
    LAS float* ydummy = (LAS float*)(lds + SC_YOFF + 2 * SC_CH * 128 * 4);
    const bool loader = wave >= 4; const int lt = tid & 255;
    constexpr int NCH = SEQ / SC_CH;
    ScanRegs R; ScanConst C;
    {
        const float* mu = p.mu + l * 1792; const int c = h * 64 + 2 * (lt & 31), cv = h * 64 + rq * 16 + 2 * (lt & 7);
        C.mur0 = mu[c]; C.mur1 = mu[c + 1]; C.muk0 = mu[512 + c]; C.muk1 = mu[512 + c + 1];
        C.ka0 = p.k_a[l * 512 + c]; C.ka1 = p.k_a[l * 512 + c + 1]; C.muv0 = mu[1024 + cv]; C.muv1 = mu[1024 + cv + 1];
    }
    if (loader) { scan_load(p, R, b, h, rq, 0, lt); scan_write(R, C, buf0, lt); scan_load(p, R, b, h, rq, 1, lt); }
    __syncthreads();
    float S0 = 0.f, S1 = 0.f, S2 = 0.f, S3 = 0.f;
    const int row = (wave & 3) * 4 + (lane >> 4), c4 = (lane & 15) * 4;
    for (int ch = 0; ch < NCH; ++ch) {
        const int par = ch & 1;
        LAS float* cur = buf0 + par * (SC_BUF_BYTES / 4); LAS float* nxt = buf0 + (par ^ 1) * (SC_BUF_BYTES / 4);
        LAS float* ycur = yb0 + par * (SC_CH * 128); LAS float* yprev = yb0 + (par ^ 1) * (SC_CH * 128);
        if (loader) {
            if (ch + 1 < NCH) scan_write(R, C, nxt, lt);
            if (ch + 2 < NCH) scan_load(p, R, b, h, rq, ch + 2, lt);
            if (ch > 0) scan_flush(p, yprev, b, h, rq, ch - 1, lt);
        } else {
            LAS float* yp = ((lane & 15) < 8) ? (ycur + row * 8 + (lane & 15)) : (ydummy + lane);
            StepOps A, B, Cc;
            SC_LD(A, 0); SC_LD(B, 1);
#pragma unroll
            for (int s = 0; s < SC_CH; s += 3) {
                if (s + 2 < SC_CH) SC_LD(Cc, s + 2);
                SC_STEP(A, s);
                if (s + 3 < SC_CH) SC_LD(A, s + 3);
                if (s + 1 < SC_CH) SC_STEP(B, s + 1);
                if (s + 4 < SC_CH) SC_LD(B, s + 4);
                if (s + 2 < SC_CH) SC_STEP(Cc, s + 2);
            }
        }
        LDS_BARRIER();
    }
    if (loader) scan_flush(p, yb1, b, h, rq, NCH - 1, lt);
    __syncthreads();
}

template <int DQK, bool SBK>
__device__ __forceinline__ void attn_unit(LAS unsigned char* lds, const bf16_t* Q, const bf16_t* K, const bf16_t* V, int ldq, int ldk, int ldv, bf16_t* O, int qb) {
    constexpr int KSTR = DQK + 8;
    constexpr int VSTR = 68;
    constexpr int NKS = DQK / 16, KCH = DQK / 8;
    LAS bf16_t* Ks = (LAS bf16_t*)lds; LAS bf16_t* Vt = (LAS bf16_t*)(lds + 64 * KSTR * 2);
    int tid_ = threadIdx.x; asm volatile("" : "+v"(tid_)); const int tid = tid_, lane = tid & 63, wave = tid >> 6, l31 = lane & 31, hh = lane >> 5;
    const int q0 = qb * 256 + wave * 32, tq = q0 + l31, qchunk = q0 >> 6;
    bf16x8 qf[NKS];
#pragma unroll
    for (int ks = 0; ks < NKS; ++ks) qf[ks] = *(const bf16x8*)(Q + (size_t)tq * ldq + ks * 16 + hh * 8);
    f32x16 o0, o1;
#pragma unroll
    for (int i = 0; i < 16; ++i) { o0[i] = 0.f; o1[i] = 0.f; }
    float m_run = -1e30f, l_run = 0.f, R = 0.f;
    bool wdone = false;
    volatile LAS int* dflags = (volatile LAS int*)(lds + 64 * KSTR * 2 + 64 * VSTR * 2);
    const int ntiles = 4 * qb + 4;
    const int kr0 = tid / KCH, kc0 = tid % KCH, kr1 = (tid + NTHR) / KCH, kc1 = (tid + NTHR) % KCH;
    const bool two = (64 * KCH > NTHR) && (tid + NTHR < 64 * KCH);
    const int vr = tid >> 3, vc = tid & 7;
    u32x4 kreg0, kreg1 = {0u, 0u, 0u, 0u}, vreg;
    int kt = SBK ? ntiles - 1 : 0;
    kreg0 = *(const u32x4*)(K + (size_t)(kt * 64 + kr0) * ldk + kc0 * 8);
    if (two) kreg1 = *(const u32x4*)(K + (size_t)(kt * 64 + kr1) * ldk + kc1 * 8);
    vreg = *(const u32x4*)(V + (size_t)(kt * 64 + vr) * ldv + vc * 8);
    for (int it = 0; it < ntiles; ++it) {
        *(LAS u32x4*)(Ks + kr0 * KSTR + kc0 * 8) = kreg0;
        if (two) *(LAS u32x4*)(Ks + kr1 * KSTR + kc1 * 8) = kreg1;
#pragma unroll
        for (int j = 0; j < 4; ++j) {
            Vt[(vc * 8 + 2 * j) * VSTR + vr] = (bf16_t)(vreg[j] & 0xffffu);
            Vt[(vc * 8 + 2 * j + 1) * VSTR + vr] = (bf16_t)(vreg[j] >> 16);
        }
        __syncthreads();
        const int ktn = SBK ? kt - 1 : kt + 1;
        if (it + 1 < ntiles) {
            kreg0 = *(const u32x4*)(K + (size_t)(ktn * 64 + kr0) * ldk + kc0 * 8);
            if (two) kreg1 = *(const u32x4*)(K + (size_t)(ktn * 64 + kr1) * ldk + kc1 * 8);
            vreg = *(const u32x4*)(V + (size_t)(ktn * 64 + vr) * ldv + vc * 8);
        }
        if (kt <= qchunk && !wdone) {
            f32x16 p0, p1;
#pragma unroll
            for (int i = 0; i < 16; ++i) { p0[i] = 0.f; p1[i] = 0.f; }
#pragma unroll
            for (int ks = 0; ks < NKS; ++ks) {
                const bf16x8 k0f = *(const LAS bf16x8*)(Ks + l31 * KSTR + ks * 16 + hh * 8);
                const bf16x8 k1f = *(const LAS bf16x8*)(Ks + (32 + l31) * KSTR + ks * 16 + hh * 8);
                p0 = __builtin_amdgcn_mfma_f32_32x32x16_bf16(k0f, qf[ks], p0, 0, 0, 0);
                p1 = __builtin_amdgcn_mfma_f32_32x32x16_bf16(k1f, qf[ks], p1, 0, 0, 0);
            }
            if (!SBK) {
                float mx = p0[0];
#pragma unroll
                for (int i = 1; i < 16; ++i) mx = fmaxf(mx, p0[i]);
#pragma unroll
                for (int i = 0; i < 16; ++i) mx = fmaxf(mx, p1[i]);
                mx = fmaxf(mx, __shfl_xor(mx, 32));
                const float m_new = fmaxf(m_run, mx), alpha = __builtin_amdgcn_exp2f(m_run - m_new);
                m_run = m_new; l_run *= alpha;
#pragma unroll
                for (int i = 0; i < 16; ++i) { o0[i] *= alpha; o1[i] *= alpha; }
                float ls = 0.f;
#pragma unroll
                for (int i = 0; i < 16; ++i) { p0[i] = __builtin_amdgcn_exp2f(p0[i] - m_new); p1[i] = __builtin_amdgcn_exp2f(p1[i] - m_new); ls += p0[i] + p1[i]; }
                l_run += ls;
            } else {
                const bool diag = (kt == qchunk);
#pragma unroll
                for (int half = 1; half >= 0; --half) {
                    f32x16& pp = half ? p1 : p0;
                    const int kbase = kt * 64 + half * 32 + 4 * hh;
                    float z[16], ls[16];
#pragma unroll
                    for (int i = 0; i < 16; ++i) {
                        z[i] = pp[i] * 0.125f;
                        const bool valid = !diag || (kbase + (i & 3) + 8 * (i >> 2) < tq);
                        ls[i] = valid ? -softplusf_(z[i]) : 0.f;
                        if (!valid) z[i] = -1e30f;
                    }
                    float g[4], og[4];
#pragma unroll
                    for (int i = 0; i < 4; ++i) { g[i] = (ls[4 * i] + ls[4 * i + 1]) + (ls[4 * i + 2] + ls[4 * i + 3]); og[i] = __shfl_xor(g[i], 32); }
                    float tail = 0.f;
#pragma unroll
                    for (int i = 3; i >= 0; --i) {
                        float run = R + tail + (hh == 0 ? og[i] : 0.f);
#pragma unroll
                        for (int r = 3; r >= 0; --r) { run += ls[4 * i + r]; pp[4 * i + r] = __expf(z[4 * i + r] + run); }
                        tail += g[i] + og[i];
                    }
                    R += tail;
                }
            }
#pragma unroll
            for (int half = 0; half < 2; ++half) {
                const f32x16& pp = half ? p1 : p0;
#pragma unroll
                for (int s = 0; s < 2; ++s) {
                    u32x4 pw; pw.x = cvt_pk_bf16(pp[8 * s + 0], pp[8 * s + 1]); pw.y = cvt_pk_bf16(pp[8 * s + 2], pp[8 * s + 3]);
                    pw.z = cvt_pk_bf16(pp[8 * s + 4], pp[8 * s + 5]); pw.w = cvt_pk_bf16(pp[8 * s + 6], pp[8 * s + 7]);
                    const bf16x8 pf = __builtin_bit_cast(bf16x8, pw);
                    const int koff = half * 32 + 16 * s + 4 * hh;
                    u32x4 va, vb;
                    const u32x2 a0 = *(const LAS u32x2*)(Vt + l31 * VSTR + koff), a1 = *(const LAS u32x2*)(Vt + l31 * VSTR + koff + 8);
                    const u32x2 b0 = *(const LAS u32x2*)(Vt + (32 + l31) * VSTR + koff), b1 = *(const LAS u32x2*)(Vt + (32 + l31) * VSTR + koff + 8);
                    va.x = a0.x; va.y = a0.y; va.z = a1.x; va.w = a1.y; vb.x = b0.x; vb.y = b0.y; vb.z = b1.x; vb.w = b1.y;
                    o0 = __builtin_amdgcn_mfma_f32_32x32x16_bf16(__builtin_bit_cast(bf16x8, va), pf, o0, 0, 0, 0);
                    o1 = __builtin_amdgcn_mfma_f32_32x32x16_bf16(__builtin_bit_cast(bf16x8, vb), pf, o1, 0, 0, 0);
                }
            }
        }
        if (SBK) {
            if (kt <= qchunk && !wdone) wdone = __all(R < -45.f);
            if (lane == 0) dflags[wave] = wdone ? 1 : 0;
        }
        __syncthreads();
        if (SBK) {
            int alld = 1;
#pragma unroll
            for (int w = 0; w < 8; ++w) alld &= dflags[w];
            if (alld) break;
        }
        kt = ktn;
    }
    float inv = 1.f;
    if (!SBK) { const float lt = l_run + __shfl_xor(l_run, 32); inv = 1.f / lt; }
    bf16_t* orow = O + (size_t)tq * 1024;
#pragma unroll
    for (int i = 0; i < 4; ++i) {
        u32x2 w0, w1;
        w0.x = cvt_pk_bf16(o0[4 * i] * inv, o0[4 * i + 1] * inv); w0.y = cvt_pk_bf16(o0[4 * i + 2] * inv, o0[4 * i + 3] * inv);
        w1.x = cvt_pk_bf16(o1[4 * i] * inv, o1[4 * i + 1] * inv); w1.y = cvt_pk_bf16(o1[4 * i + 2] * inv, o1[4 * i + 3] * inv);
        *(u32x2*)(orow + 8 * i + 4 * hh) = w0;
        *(u32x2*)(orow + 32 + 8 * i + 4 * hh) = w1;
    }
}

__device__ __forceinline__ void conv_item(const Params& p, int l, LAS unsigned char* lds, int part, int nparts) {
    int tid_ = threadIdx.x; asm volatile("" : "+v"(tid_)); const int tid = tid_, lane = tid & 63, wave = tid >> 6;
    const int gw = part * 8 + wave, ngw = nparts * 8;
    unsigned char* ws = p.ws;
    LAS float* scr = (LAS float*)(lds + wave * 8448);
    conv_run(p.w_o + (size_t)l * 1024 * 1024, nullptr, nullptr, (bf16_t*)(ws + WS_WO), 1024, 1024, 1024, 0, scr, gw, ngw, lane);
    conv_run(p.w_gate + (size_t)l * 1024 * FF, p.w_upf + (size_t)l * 1024 * FF, p.ffn_g + l * 1024, (bf16_t*)(ws + WS_WGU), 1024, FF, 2 * FF, 2, scr, gw, ngw, lane);
    conv_run(p.w_down + (size_t)l * FF * 1024, nullptr, nullptr, (bf16_t*)(ws + WS_WDN), FF, 1024, 1024, 0, scr, gw, ngw, lane);
    if (l + 1 < DEPTH) conv_run(p.w_in + (size_t)(l + 1) * 1024 * INC, nullptr, p.attn_norm_g + (l + 1) * 1024, (bf16_t*)(ws + WS_WIN), 1024, INC, 3072, 1, scr, gw, ngw, lane);
    __syncthreads();
}
__device__ __forceinline__ void phase_mixer(const Params& p, int l, LAS unsigned char* lds) {
    unsigned char* ws = p.ws;
    unsigned* ctr = (unsigned*)(ws + WS_CTR) + l;
    volatile LAS int* s_item = (volatile LAS int*)(lds + LDS_ITEM_OFF);
    const bf16_t* hbig = (const bf16_t*)(ws + WS_HBIG);
    bf16_t* mixed = (bf16_t*)(ws + WS_MIXED);
    for (;;) {
        if (threadIdx.x == 0) *s_item = (int)atomicAdd(ctr, 1u);
        __syncthreads();
        const int item = *s_item;
        __syncthreads();
        if (item >= P2_ITEMS) break;
        if (item < 128) {
#ifndef SKIP_SCAN
            scan_unit(p, l, lds, item);
#endif
            continue; }
#ifdef SKIP_ATTN
        continue;
#endif
        if (item >= 640) { conv_item(p, l, lds, item - 640, P2_CONV); continue; }
        const int a = item - 128, qb = 15 - (a >> 5), kind = (a >> 4) & 1, bh = a & 15, b = bh >> 2, hd = bh & 3;
        if (kind == 0) {
            const bf16_t* base = hbig + (size_t)b * SEQ * HB + hd * 64;
#ifndef SKIP_SB
            attn_unit<64, true>(lds, base + 1536, base + 1792, base + 2048, HB, HB, HB, mixed + (size_t)b * SEQ * 1024 + 768 + hd * 64, qb);
#endif
        } else {
            const bf16_t* q = (const bf16_t*)(ws + WS_MLA + MLA_Q) + (size_t)bh * SEQ * 96;
            const bf16_t* k = (const bf16_t*)(ws + WS_MLA + MLA_K) + (size_t)bh * SEQ * 96;
            const bf16_t* v = (const bf16_t*)(ws + WS_MLA + MLA_V) + (size_t)bh * SEQ * 64;
#ifdef FAKE_MLA
            { bf16_t* O = mixed + (size_t)b * SEQ * 1024 + 512 + hd * 64;
              for (int e = threadIdx.x; e < 256 * 64; e += NTHR) { const int tq = qb * 256 + (e >> 6), dv = e & 63;
                const float val = bf1(v[(size_t)tq * 64 + dv]) + bf1(q[(size_t)tq * 96 + dv]) + bf1(q[(size_t)tq * 96 + dv + 32]) + bf1(k[(size_t)tq * 96 + dv]) + bf1(k[(size_t)tq * 96 + dv + 32]);
                O[(size_t)tq * 1024 + dv] = f2bf(val); } }
#elif !defined(SKIP_MLA)
            attn_unit<96, false>(lds, q, k, v, 96, 96, 64, mixed + (size_t)b * SEQ * 1024 + 512 + hd * 64, qb);
#endif
        }
    }
}

__device__ __forceinline__ void phase_finalize(const Params& p, int l) {
    int tid_ = threadIdx.x; asm volatile("" : "+v"(tid_)); const int tid = tid_, lane = tid & 63, wave = tid >> 6;
    const int gw = blockIdx.x * 8 + wave, ngw = gridDim.x * 8;
    unsigned char* ws = p.ws;
    const bf16_t* hbig = (const bf16_t*)(ws + WS_HBIG);
    const bf16_t* s_a = (const bf16_t*)(ws + WS_STREAMS + STREAM_BYTES);
    const bf16_t* s_g = (const bf16_t*)(ws + WS_STREAMS + 3 * STREAM_BYTES);
    bf16_t* mixed = (bf16_t*)(ws + WS_MIXED);
    const float* mu = p.mu + l * 1792;
    const int c0 = lane * 8;
#pragma unroll 2
    for (int tok = gw; tok < NTOK; tok += ngw) {
        const int t = tok & (SEQ - 1);
        const u32x4 yv = *(const u32x4*)(mixed + (size_t)tok * 1024 + c0);
        float y[8];
#pragma unroll
        for (int j = 0; j < 4; ++j) { y[2 * j] = bflo(yv[j]); y[2 * j + 1] = bfhi(yv[j]); }
        float s = 0.f;
#pragma unroll
        for (int j = 0; j < 8; ++j) s += y[j];
        s += __shfl_xor(s, 1); s += __shfl_xor(s, 2); s += __shfl_xor(s, 4);
        const float mean = s * (1.f / 64.f);
        float q = 0.f;
#pragma unroll
        for (int j = 0; j < 8; ++j) { y[j] -= mean; q += y[j] * y[j]; }
        q += __shfl_xor(q, 1); q += __shfl_xor(q, 2); q += __shfl_xor(q, 4);
        const float rstd = rsqrtf(q * (1.f / 64.f) + 64e-5f);
        const bf16_t* hr = hbig + (size_t)tok * HB + c0;
        const u32x4 rc = *(const u32x4*)(hr), kc = *(const u32x4*)(hr + 512), vc = *(const u32x4*)(hr + 1024);
        u32x4 rp = {0u, 0u, 0u, 0u}, kp = rp, vp = rp;
        if (t > 0) { rp = *(const u32x4*)(hr - HB); kp = *(const u32x4*)(hr - HB + 512); vp = *(const u32x4*)(hr - HB + 1024); }
        const u32x4 av = *(const u32x4*)(s_a + (size_t)tok * 512 + c0), gv = *(const u32x4*)(s_g + (size_t)tok * 512 + c0);
        float vv[8], gg[8]; float bs = 0.f;
#pragma unroll
        for (int j = 0; j < 8; ++j) {
            const int w = j >> 1; const bool hi = j & 1; const int c = c0 + j;
            const float r_ = shiftf(hi ? bfhi(rc[w]) : bflo(rc[w]), hi ? bfhi(rp[w]) : bflo(rp[w]), mu[c]);
            const float ks = shiftf(hi ? bfhi(kc[w]) : bflo(kc[w]), hi ? bfhi(kp[w]) : bflo(kp[w]), mu[512 + c]);
            vv[j] = shiftf(hi ? bfhi(vc[w]) : bflo(vc[w]), hi ? bfhi(vp[w]) : bflo(vp[w]), mu[1024 + c]);
            const float a_ = hi ? bfhi(av[w]) : bflo(av[w]);
            gg[j] = hi ? bfhi(gv[w]) : bflo(gv[w]);
            const float k_ = ks * (1.f + (a_ - 1.f) * p.k_a[l * 512 + c]);
            bs += r_ * k_ * p.r_k[l * 512 + c];
        }
        bs += __shfl_xor(bs, 1); bs += __shfl_xor(bs, 2); bs += __shfl_xor(bs, 4);
        float o[8];
#pragma unroll
        for (int j = 0; j < 8; ++j) o[j] = (y[j] * rstd * p.ln_g[l * 512 + c0 + j] + p.ln_b[l * 512 + c0 + j] + bs * vv[j]) * gg[j];
        u32x4 w; w.x = cvt_pk_bf16(o[0], o[1]); w.y = cvt_pk_bf16(o[2], o[3]); w.z = cvt_pk_bf16(o[4], o[5]); w.w = cvt_pk_bf16(o[6], o[7]);
        *(u32x4*)(mixed + (size_t)tok * 1024 + c0) = w;
    }
}


__device__ __forceinline__ void grid_barrier(unsigned char* ws, unsigned& epoch) {
    asm volatile("s_waitcnt vmcnt(0) lgkmcnt(0)" ::: "memory");
    __syncthreads();
    if (threadIdx.x == 0) {
        __builtin_amdgcn_fence(__ATOMIC_RELEASE, "agent");
        unsigned* base = (unsigned*)(ws + WS_BAR);
        const unsigned g = blockIdx.x & 15u, ng = gridDim.x >> 4;
        const unsigned old = __hip_atomic_fetch_add(base + 64 * (1 + g), 1u, __ATOMIC_RELAXED, __HIP_MEMORY_SCOPE_AGENT);
        if (old == epoch * ng + ng - 1) {
            const unsigned t = __hip_atomic_fetch_add(base + 64 * 17, 1u, __ATOMIC_RELAXED, __HIP_MEMORY_SCOPE_AGENT);
            if (t == epoch * 16u + 15u) {
#pragma unroll
                for (unsigned q = 0; q < 16u; ++q) __hip_atomic_store(base + 64 * (18 + q), epoch + 1u, __ATOMIC_RELAXED, __HIP_MEMORY_SCOPE_AGENT);
            }
        }
        while (__hip_atomic_load(base + 64 * (18 + g), __ATOMIC_RELAXED, __HIP_MEMORY_SCOPE_AGENT) < epoch + 1u) __builtin_amdgcn_s_sleep(1);
        __builtin_amdgcn_fence(__ATOMIC_ACQUIRE, "agent");
    }
    __syncthreads();
    ++epoch;
}
__global__ void __launch_bounds__(NTHR, 2) fwd_megakernel(Params p) {
    extern __shared__ __attribute__((aligned(16))) unsigned char lds_raw[];
    LAS unsigned char* lds = (LAS unsigned char*)lds_raw;
    cg::grid_group grid = cg::this_grid();
    unsigned char* ws = p.ws;
    unsigned long long* ssq = (unsigned long long*)(ws + WS_SSQ64);
    bf16_t* xb = (bf16_t*)(ws + WS_XB);
    const int G = gridDim.x, bid = blockIdx.x;
    int ph = 0; unsigned bar_epoch = 0u;
#define PHASE_BEGIN if (ph >= p.ph_lo && ph < p.ph_hi) {
#define PHASE_END   if (ph + 1 < p.ph_hi) { if (ph == 0) { asm volatile("s_waitcnt vmcnt(0)" ::: "memory"); grid.sync(); } else grid_barrier(ws, bar_epoch); } } ++ph;

    PHASE_BEGIN phase_prologue(p, lds); PHASE_END
    for (int l = 0; l < DEPTH; ++l) {
        PHASE_BEGIN
            pg8::Gemm g{xb, (const bf16_t*)(ws + WS_WIN), NTOK, 3072, 1024}; pg8::StaticOrder S; S.init(NTOK, 3072, G, bid);
            EpiH E{(bf16_t*)(ws + WS_HBIG), (bf16_t*)(ws + WS_HSMALL), ssq + (size_t)(2 * l) * NTOK};
            pg8::gemm_phase<EpiH, pg8::StaticOrder, true, true>(lds, g, S, E);
        PHASE_END
        PHASE_BEGIN
#if defined(SKIP_SCAN) || defined(SKIP_ATTN) || defined(SKIP_MLA) || defined(SKIP_SB)
        { u32x4 z = {0u,0u,0u,0u}; u32x4* mz = (u32x4*)(ws + WS_MIXED); for (size_t i = (size_t)blockIdx.x * NTHR + threadIdx.x; i < (size_t)NTOK * 1024 * 2 / 16; i += (size_t)gridDim.x * NTHR) mz[i] = z; }
#endif
        phase_prep(p, l, lds); PHASE_END
#ifdef SKIP_P2
        PHASE_BEGIN { u32x4 z = {0u,0u,0u,0u}; u32x4* mz = (u32x4*)(ws + WS_MIXED); for (size_t i = (size_t)blockIdx.x * NTHR + threadIdx.x; i < (size_t)NTOK * 1024 * 2 / 16; i += (size_t)gridDim.x * NTHR) mz[i] = z; } PHASE_END
#else
        PHASE_BEGIN phase_mixer(p, l, lds); PHASE_END
#endif
        PHASE_BEGIN phase_finalize(p, l); PHASE_END
        PHASE_BEGIN
            pg8::Gemm g{(const bf16_t*)(ws + WS_MIXED), (const bf16_t*)(ws + WS_WO), NTOK, 1024, 1024}; pg8::StaticOrder S; S.init(NTOK, 1024, G, bid);
            EpiRes E{l == 0 ? p.x : p.out, p.out, xb, ssq + (size_t)(2 * l + 1) * NTOK};
            pg8::gemm_phase<EpiRes, pg8::StaticOrder, true, true>(lds, g, S, E);
        PHASE_END
        PHASE_BEGIN
            pg8::Gemm g{xb, (const bf16_t*)(ws + WS_WGU), NTOK, 2 * FF, 1024}; pg8::StaticOrder S; S.init(NTOK, 2 * FF, G, bid);
            EpiGLU E{(bf16_t*)(ws + WS_ACT), ssq + (size_t)(2 * l + 1) * NTOK};
            pg8::gemm_phase<EpiGLU, pg8::StaticOrder, true, true>(lds, g, S, E);
        PHASE_END
        PHASE_BEGIN
            pg8::Gemm g{(const bf16_t*)(ws + WS_ACT), (const bf16_t*)(ws + WS_WDN), NTOK, 1024, FF}; pg8::StaticOrder S; S.init(NTOK, 1024, G, bid);
            EpiRes E{p.out, p.out, xb, ssq + (size_t)(2 * l + 2) * NTOK};
            pg8::gemm_phase<EpiRes, pg8::StaticOrder, true, true>(lds, g, S, E);
        PHASE_END
    }
}
constexpr int N_PHASES = 1 + 7 * DEPTH;

#ifndef MK_MULTI
#define MK_MULTI 0
#endif
extern "C" void kernel_launch(void* const* d_in, const int* in_sizes, int n_in, void* d_out, int out_size, void* d_ws, size_t ws_size, hipStream_t stream) {
    static int grid = 0;
    if (grid == 0) {
        if (n_in != 26 || ws_size < WS_END) { fprintf(stderr, "kernel_launch: unexpected inputs (n_in %d, ws %zu)\n", n_in, ws_size); grid = -1; return; }
        if (hipFuncSetAttribute((const void*)fwd_megakernel, hipFuncAttributeMaxDynamicSharedMemorySize, LDS_BYTES) != hipSuccess) { fprintf(stderr, "hipFuncSetAttribute failed\n"); grid = -1; return; }
        int dev = 0, cus = 0, per_cu = 0;
        hipGetDevice(&dev); hipDeviceGetAttribute(&cus, hipDeviceAttributeMultiprocessorCount, dev);
        hipOccupancyMaxActiveBlocksPerMultiprocessor(&per_cu, (const void*)fwd_megakernel, NTHR, LDS_BYTES);
        (void)hipGetLastError();
        if (per_cu < 1) fprintf(stderr, "occupancy query says %d blocks/CU\n", per_cu);
        grid = cus > 0 ? cus : 256;
    }
    if (grid < 0) return;
    Params p{};
    p.x = (const float*)d_in[0]; p.pos = (const int*)d_in[1]; p.attn_norm_g = (const float*)d_in[2]; p.w_in = (const float*)d_in[3];
    p.mu = (const float*)d_in[4]; p.w_up = (const float*)d_in[5]; p.w0 = (const float*)d_in[6]; p.a_up = (const float*)d_in[7];
    p.a0 = (const float*)d_in[8]; p.g_up = (const float*)d_in[9]; p.k_k = (const float*)d_in[10]; p.k_a = (const float*)d_in[11];
    p.r_k = (const float*)d_in[12]; p.ln_g = (const float*)d_in[13]; p.ln_b = (const float*)d_in[14]; p.cq_g = (const float*)d_in[15];
    p.ckv_g = (const float*)d_in[16]; p.w_uq = (const float*)d_in[17]; p.w_ukv = (const float*)d_in[18]; p.qn_g = (const float*)d_in[19];
    p.kn_g = (const float*)d_in[20]; p.w_o = (const float*)d_in[21]; p.ffn_g = (const float*)d_in[22]; p.w_gate = (const float*)d_in[23];
    p.w_upf = (const float*)d_in[24]; p.w_down = (const float*)d_in[25];
    p.out = (float*)d_out; p.ws = (unsigned char*)d_ws;
#if MK_MULTI
    for (int ph = 0; ph < N_PHASES; ++ph) {
        p.ph_lo = ph; p.ph_hi = ph + 1;
        hipLaunchKernelGGL(fwd_megakernel, dim3(grid), dim3(NTHR), LDS_BYTES, stream, p);
    }
#else
    p.ph_lo = 0; p.ph_hi = N_PHASES;
    if (hipMemsetAsync((unsigned char*)d_ws + WS_BAR, 0, 12288, stream) != hipSuccess) { fprintf(stderr, "memset of barrier words failed\n"); return; }
    void* args[] = {&p};
    hipError_t e = hipLaunchCooperativeKernel((const void*)fwd_megakernel, dim3(grid), dim3(NTHR), args, LDS_BYTES, stream);
    if (e != hipSuccess) fprintf(stderr, "cooperative launch failed: %s (grid %d)\n", hipGetErrorString(e), grid);
#endif
}
```
